# Optimizing an MI355X kernel written in HIP

```python
import jax, jax.numpy as jnp
from jax import lax
import numpy as np

D_MODEL = 1024
BATCH = 2
SEQ = 8192
DEPTH = 1
DEC_BATCH = 8
DEC_SEQ = 8192
PAST_LEN = 128

GRID_W = 64
POOL_WINDOWS = (2, 4, 8, 16)
POOL_GROUPS = 4
D_POOL = D_MODEL // 2
POOL_GROUP_C = D_POOL // POOL_GROUPS
POOL_OUT_C = D_MODEL // POOL_GROUPS
N_HEADS = D_MODEL // 128
D_ATT_QK = D_MODEL // 2
HEAD_DIM_QK = D_ATT_QK // N_HEADS
HEAD_DIM_V = D_MODEL // N_HEADS
NA_WIN_H = 8
NA_WIN_W = 16
D_IN = D_POOL + 2 * D_ATT_QK + D_MODEL + 2 * D_MODEL
D_FF = ((8 * D_MODEL + 3 * 256 - 1) // (3 * 256)) * 256
EPS = 1e-6

kernel_name = "hybrid_pool_natten_encoder"


def rmsnorm(x, g):
    x32 = x.astype(jnp.float32)
    y = x32 * lax.rsqrt(jnp.mean(x32 * x32, axis=-1, keepdims=True) + EPS)
    return (y * g.astype(jnp.float32)).astype(x.dtype)


def multiscale_pool(u, w_grp, scale):
    B, S, _ = u.shape
    u32 = u.astype(jnp.float32)
    cs = jnp.concatenate([jnp.zeros((B, 1, D_POOL), jnp.float32), jnp.cumsum(u32, axis=1)], axis=1)
    t = jnp.arange(S)
    outs = []
    for g, w in enumerate(POOL_WINDOWS):
        lo = jnp.clip(t - w // 2, 0, S)
        hi = jnp.clip(t + w // 2, 0, S)
        sl = slice(g * POOL_GROUP_C, (g + 1) * POOL_GROUP_C)
        csg = cs[:, :, sl]
        win_sum = jnp.take(csg, hi, axis=1) - jnp.take(csg, lo, axis=1)
        cnt = (hi - lo).astype(jnp.float32)[None, :, None]
        outs.append(win_sum / cnt - u32[:, :, sl])
    pooled = jnp.stack(outs, axis=2).astype(u.dtype)
    y = jnp.einsum('bsgc,gcd->bsgd', pooled, w_grp)
    return y.reshape(B, S, D_MODEL) * scale


def neighbourhood_attention(q, k, v, rpb):
    B, S = q.shape[0], q.shape[1]
    rows = S // GRID_W
    kh = min(NA_WIN_H, rows)
    kw = NA_WIN_W
    qg = q.reshape(B, rows, GRID_W, N_HEADS, HEAD_DIM_QK)
    kg = k.reshape(B, rows, GRID_W, N_HEADS, HEAD_DIM_QK)
    vg = v.reshape(B, rows, GRID_W, N_HEADS, HEAD_DIM_V)
    cols = jnp.arange(GRID_W)
    col_start = jnp.clip(cols - kw // 2, 0, GRID_W - kw)
    col_idx = col_start[:, None] + jnp.arange(kw)[None, :]
    dc = col_idx - cols[:, None]
    row_start = jnp.clip(jnp.arange(rows) - kh // 2, 0, rows - kh)
    rpb_c = rpb[:, :, dc + (NA_WIN_W - 1)]
    scale = HEAD_DIM_QK ** -0.5

    def one_row(r):
        rs = row_start[r]
        q_r = lax.dynamic_index_in_dim(qg, r, axis=1, keepdims=False)
        k_blk = lax.dynamic_slice_in_dim(kg, rs, kh, axis=1)
        v_blk = lax.dynamic_slice_in_dim(vg, rs, kh, axis=1)
        k_nb = k_blk[:, :, col_idx]
        v_nb = v_blk[:, :, col_idx]
        s = jnp.einsum('bchd,bkcjhd->bhckj', q_r, k_nb).astype(jnp.float32) * scale
        dr = rs + jnp.arange(kh) - r
        bias = rpb_c[:, dr + (NA_WIN_H - 1)]
        s = s + jnp.transpose(bias, (0, 2, 1, 3))[None].astype(jnp.float32)
        p = jax.nn.softmax(s.reshape(B, N_HEADS, GRID_W, kh * kw), axis=-1)
        p = p.reshape(B, N_HEADS, GRID_W, kh, kw).astype(v.dtype)
        return jnp.einsum('bhckj,bkcjhe->bche', p, v_nb)

    out = lax.map(one_row, jnp.arange(rows))
    return jnp.transpose(out, (1, 0, 2, 3, 4)).reshape(B, S, N_HEADS * HEAD_DIM_V)


def encoder_layer(x, norm_mix_pre, w_in, w_pool_grp, pool_scale, attn_rpb, w_out,
                  norm_mix_post, norm_ffn_pre, w_gate_up, w_down, norm_ffn_post):
    B, S, _ = x.shape
    h = rmsnorm(x, norm_mix_pre)
    z = h @ w_in
    o1 = D_POOL
    o2 = o1 + D_ATT_QK
    o3 = o2 + D_ATT_QK
    o4 = o3 + D_MODEL
    o5 = o4 + D_MODEL
    u_pool = z[..., :o1]
    q = z[..., o1:o2].reshape(B, S, N_HEADS, HEAD_DIM_QK)
    k = z[..., o2:o3].reshape(B, S, N_HEADS, HEAD_DIM_QK)
    v = z[..., o3:o4].reshape(B, S, N_HEADS, HEAD_DIM_V)
    g_pool = jax.nn.sigmoid(z[..., o4:o5])
    g_attn = jax.nn.sigmoid(z[..., o5:])
    a = multiscale_pool(u_pool, w_pool_grp, pool_scale)
    b = neighbourhood_attention(q, k, v, attn_rpb)
    m = g_pool * a + g_attn * b
    x = x + rmsnorm(m @ w_out, norm_mix_post)
    h = rmsnorm(x, norm_ffn_pre)
    gu = h @ w_gate_up
    f = (jax.nn.silu(gu[..., :D_FF]) * gu[..., D_FF:]) @ w_down
    return x + rmsnorm(f, norm_ffn_post)


def trunk(x, norm_mix_pre, w_in, w_pool_grp, pool_scale, attn_rpb, w_out,
          norm_mix_post, norm_ffn_pre, w_gate_up, w_down, norm_ffn_post):
    for l in range(DEPTH):
        x = encoder_layer(x, norm_mix_pre[l], w_in[l], w_pool_grp[l], pool_scale[l], attn_rpb[l],
                          w_out[l], norm_mix_post[l], norm_ffn_pre[l], w_gate_up[l], w_down[l],
                          norm_ffn_post[l])
    return x


def setup_inputs(seed: int = 0) -> dict:
    key = jax.random.key(seed)
    ks = jax.random.split(key, 14)
    f32 = jnp.float32

    def nrm(k, shape, s):
        return jax.random.normal(k, shape, f32) * s

    def gain(k):
        return 1.0 + nrm(k, (DEPTH, D_MODEL), 0.05)

    return {
        "x_prompt": nrm(ks[0], (BATCH, SEQ, D_MODEL), 1.0),
        "x_sample": nrm(ks[1], (DEC_BATCH, DEC_SEQ, D_MODEL), 1.0),
        "norm_mix_pre": gain(ks[2]),
        "w_in": nrm(ks[3], (DEPTH, D_MODEL, D_IN), D_MODEL ** -0.5),
        "w_pool_grp": nrm(ks[4], (DEPTH, POOL_GROUPS, POOL_GROUP_C, POOL_OUT_C), POOL_GROUP_C ** -0.5),
        "pool_scale": 1.0 + nrm(ks[5], (DEPTH, D_MODEL), 0.1),
        "attn_rpb": nrm(ks[6], (DEPTH, N_HEADS, 2 * NA_WIN_H - 1, 2 * NA_WIN_W - 1), 0.5),
        "w_out": nrm(ks[7], (DEPTH, D_MODEL, D_MODEL), D_MODEL ** -0.5),
        "norm_mix_post": gain(ks[8]),
        "norm_ffn_pre": gain(ks[9]),
        "w_gate_up": nrm(ks[10], (DEPTH, D_MODEL, 2 * D_FF), D_MODEL ** -0.5),
        "w_down": nrm(ks[11], (DEPTH, D_FF, D_MODEL), D_FF ** -0.5),
        "norm_ffn_post": gain(ks[12]),
    }


def reference(x_prompt, x_sample, norm_mix_pre, w_in, w_pool_grp, pool_scale, attn_rpb, w_out,
              norm_mix_post, norm_ffn_pre, w_gate_up, w_down, norm_ffn_post):
    y_prompt = trunk(x_prompt, norm_mix_pre, w_in, w_pool_grp, pool_scale, attn_rpb, w_out,
                     norm_mix_post, norm_ffn_pre, w_gate_up, w_down, norm_ffn_post)
    y_sample = trunk(x_sample, norm_mix_pre, w_in, w_pool_grp, pool_scale, attn_rpb, w_out,
                     norm_mix_post, norm_ffn_pre, w_gate_up, w_down, norm_ffn_post)
    return (y_prompt, y_sample)
```

```cpp
#include <hip/hip_runtime.h>
#include <hip/hip_cooperative_groups.h>
#include <cstdio>
#include <cstdint>
namespace cg = cooperative_groups;
namespace pg8 {
#define PG8_LAS __attribute__((address_space(3)))
typedef unsigned short bf16_t;
typedef short bf16x8 __attribute__((ext_vector_type(8)));
typedef float f32x4 __attribute__((ext_vector_type(4)));
typedef unsigned u32x4 __attribute__((ext_vector_type(4)));
constexpr int BM = 256, BK = 64, HALF = 128, HTB = HALF * BK * 2  , STAGE_BYTES = 8 * HTB, NXCD = 8, WGM = 8;

__host__ __device__ __forceinline__ int lds_byte(int r, int c) { const int st = (r >> 4) * 2 + (c >> 5), rr = r & 15, cc = c & 31, ob = rr * 64 + cc * 2; return st * 1024 + (ob ^ (((ob >> 9) & 1) << 5)); }
__host__ __device__ __forceinline__ void stage_rc(int b, int& R, int& C) { const int st = b / 1024, sb = b % 1024, swz = sb ^ (((sb >> 9) & 1) << 5); R = (st >> 1) * 16 + swz / 64; C = (st & 1) * 32 + (swz % 64) / 2; }
__host__ __device__ __forceinline__ int perm32(int rho) { const int n = rho >> 4, i = rho & 15; return 8 * (i >> 2) + 4 * n + (i & 3); }

struct Unit { int pm, pn; };
struct Gemm { const bf16_t* A; const bf16_t* Bt; int M, N, K; };

struct StaticOrder {
    int nM, nN, nwg, G, c;
    __host__ __device__ void init(int M, int N, int G_, int c_) { nM = M / BM; nN = N / BM; nwg = nM * nN; G = G_; c = c_; }
    __host__ __device__ bool next(int i, Unit& u) const {
        const long L = (long)i * G + c; if (L >= nwg) return false;
        int wgid = (int)L; { const int q = nwg / NXCD, r = nwg % NXCD, xcd = wgid % NXCD, off = wgid / NXCD; wgid = (xcd < r ? xcd * (q + 1) : r * (q + 1) + (xcd - r) * q) + off; }
        const int nig = WGM * nN, gid = wgid / nig, fm = gid * WGM, gsz = (nM - fm) < WGM ? (nM - fm) : WGM;
        u.pm = fm + ((wgid % nig) % gsz); u.pn = (wgid % nig) / gsz; return true;
    }
    __device__ __forceinline__ void a_ready(const Unit&) const {}
    __device__ __forceinline__ void done(const Unit&) const {}
};

__device__ __forceinline__ unsigned cvt_pk_bf16(float lo, float hi) { unsigned r; asm volatile("v_cvt_pk_bf16_f32 %0, %1, %2" : "=v"(r) : "v"(lo), "v"(hi)); return r; }
typedef float f32x2 __attribute__((ext_vector_type(2)));
__device__ __forceinline__ float fast_sigmoid(float v) { return __builtin_amdgcn_rcpf(1.0f + __expf(-v)); }
struct EpiPlain {
    static constexpr bool PERM = true, AFTER_DRAIN = false;
    bf16_t* O; int ldc;
    __device__ __forceinline__ void operator()(const f32x4 (&acc)[2][2][4][2], const Unit& u, int wr, int wc, int fr, int fq) const {
        const int row0 = u.pm * BM + wr * 64 + fr, col0 = u.pn * BM + wc * 32 + 8 * fq;
#pragma unroll
        for (int ai = 0; ai < 2; ++ai)
#pragma unroll
            for (int m = 0; m < 4; ++m) { bf16_t* rowp = O + (size_t)(row0 + ai * HALF + m * 16) * ldc + col0;
#pragma unroll
                for (int bj = 0; bj < 2; ++bj) { const f32x4 v0 = acc[ai][bj][m][0], v1 = acc[ai][bj][m][1];
                    u32x4 w; w.x = cvt_pk_bf16(v0[0], v0[1]); w.y = cvt_pk_bf16(v0[2], v0[3]); w.z = cvt_pk_bf16(v1[0], v1[1]); w.w = cvt_pk_bf16(v1[2], v1[3]);
                    *(u32x4*)(rowp + bj * HALF) = w; } }
    }
};
struct EpiSumsq {
    static constexpr bool PERM = true, AFTER_DRAIN = false;
    bf16_t* O; int ldc; float* ps;
    __device__ __forceinline__ void operator()(const f32x4 (&acc)[2][2][4][2], const Unit& u, int wr, int wc, int fr, int fq) const {
        const int row0 = u.pm * BM + wr * 64 + fr, col0 = u.pn * BM + wc * 32 + 8 * fq;
#pragma unroll
        for (int ai = 0; ai < 2; ++ai)
#pragma unroll
            for (int m = 0; m < 4; ++m) { const int row = row0 + ai * HALF + m * 16; bf16_t* rowp = O + (size_t)row * ldc + col0; float s = 0.f;
#pragma unroll
                for (int bj = 0; bj < 2; ++bj) { const f32x4 v0 = acc[ai][bj][m][0], v1 = acc[ai][bj][m][1];
                    s += (v0[0] * v0[0] + v0[1] * v0[1]) + (v0[2] * v0[2] + v0[3] * v0[3]) + (v1[0] * v1[0] + v1[1] * v1[1]) + (v1[2] * v1[2] + v1[3] * v1[3]);
                    u32x4 w; w.x = cvt_pk_bf16(v0[0], v0[1]); w.y = cvt_pk_bf16(v0[2], v0[3]); w.z = cvt_pk_bf16(v1[0], v1[1]); w.w = cvt_pk_bf16(v1[2], v1[3]);
                    *(u32x4*)(rowp + bj * HALF) = w; }
                s += __shfl_xor(s, 16); s += __shfl_xor(s, 32);
                if (fq == 0) ps[(size_t)row * 16 + u.pn * 4 + wc] = s; }
    }
};
struct EpiSwiglu {
    static constexpr bool PERM = true, AFTER_DRAIN = false;
    bf16_t* O; int ldc;
    __device__ __forceinline__ void operator()(const f32x4 (&acc)[2][2][4][2], const Unit& u, int wr, int wc, int fr, int fq) const {
        const int row0 = u.pm * BM + wr * 64 + fr, col0 = u.pn * HALF + wc * 32 + 8 * fq;
#pragma unroll
        for (int ai = 0; ai < 2; ++ai)
#pragma unroll
            for (int m = 0; m < 4; ++m) { bf16_t* rowp = O + (size_t)(row0 + ai * HALF + m * 16) * ldc + col0;
                float a[8];
#pragma unroll
                for (int n = 0; n < 2; ++n)
#pragma unroll
                    for (int e = 0; e < 4; ++e) { const float gt = acc[ai][0][m][n][e], up = acc[ai][1][m][n][e]; a[4 * n + e] = gt * fast_sigmoid(gt) * up; }
                u32x4 w; w.x = cvt_pk_bf16(a[0], a[1]); w.y = cvt_pk_bf16(a[2], a[3]); w.z = cvt_pk_bf16(a[4], a[5]); w.w = cvt_pk_bf16(a[6], a[7]);
                *(u32x4*)rowp = w; }
    }
};
template <class Epi, class Sched, bool ALIGN_EPI = false, bool SP2 = false>
__device__ __forceinline__ void gemm_phase(PG8_LAS unsigned char* lds, const Gemm g, const Sched& S, const Epi& E) {
    const int tid = threadIdx.x, wid = __builtin_amdgcn_readfirstlane(tid >> 6), lane = tid & 63, wr = wid >> 2, wc = wid & 3, fr = lane & 15, fq = lane >> 4;
    const int K = g.K, nt = K / BK;
    unsigned voffA[2], voffB[2];
#pragma unroll
    for (int i = 0; i < 2; ++i) { int R, C; stage_rc(tid * 16 + i * 8192, R, C); const int Rb = Epi::PERM ? ((R & ~31) + perm32(R & 31)) : R;
        voffA[i] = (unsigned)(R * K + C) * 2u; voffB[i] = (unsigned)(Rb * K + C) * 2u; }
    const size_t kstep = (size_t)(BK * 2);
    const size_t hstep = (size_t)HALF * K * 2;
    const size_t tstep = 2 * hstep;
    const unsigned ldsw = (unsigned)wid * 1024u;
    const int aoff = lds_byte(wr * 64 + fr, fq * 8), boff = lds_byte(wc * 32 + fr, fq * 8);
#define PG8_SA(b, h) (((b) * 2 + (h)) * HTB)
#define PG8_SB(b, h) ((4 + (b) * 2 + (h)) * HTB)
#define PG8_STAGE(bufoff, gbase, voff) do { _Pragma("unroll") for (int _i = 0; _i < 2; ++_i) \
        __builtin_amdgcn_global_load_lds((const unsigned*)((const char*)(gbase) + (voff)[_i]), (PG8_LAS unsigned*)(lds + (bufoff) + ldsw + _i * 8192), 16, 0, 0); } while (0)
#define PG8_LDA(dst, b, h) do { _Pragma("unroll") for (int m = 0; m < 4; ++m) _Pragma("unroll") for (int k = 0; k < 2; ++k) dst[m][k] = *(const PG8_LAS bf16x8*)(lds + PG8_SA(b, h) + aoff + m * 2048 + k * 1024); } while (0)
#define PG8_LDB(dst, b, h) do { _Pragma("unroll") for (int n = 0; n < 2; ++n) _Pragma("unroll") for (int k = 0; k < 2; ++k) dst[n][k] = *(const PG8_LAS bf16x8*)(lds + PG8_SB(b, h) + boff + n * 2048 + k * 1024); } while (0)
#define PG8_MMA(ai, bj, At, Bt) do { __builtin_amdgcn_s_setprio(1); _Pragma("unroll") for (int m = 0; m < 4; ++m) _Pragma("unroll") for (int n = 0; n < 2; ++n) _Pragma("unroll") for (int k = 0; k < 2; ++k) \
        acc[ai][bj][m][n] = __builtin_amdgcn_mfma_f32_16x16x32_bf16(Bt[n][k], At[m][k], acc[ai][bj][m][n], 0, 0, 0); __builtin_amdgcn_s_setprio(0); } while (0)
#define PG8_WAIT_V(n) asm volatile("s_waitcnt vmcnt(" #n ")" ::: "memory")
#define PG8_WAIT_L(n) asm volatile("s_waitcnt lgkmcnt(" #n ")" ::: "memory")
#define PG8_BAR __builtin_amdgcn_s_barrier()
#define PG8_SCHED __builtin_amdgcn_sched_barrier(0)
    Unit cur, nxt; int ui = 0;
    if (!S.next(0, cur)) return;
    f32x4 acc[2][2][4][2];
#pragma unroll
    for (int a = 0; a < 2; ++a)
#pragma unroll
        for (int b = 0; b < 2; ++b)
#pragma unroll
            for (int m = 0; m < 4; ++m)
#pragma unroll
                for (int n = 0; n < 2; ++n) acc[a][b][m][n] = (f32x4){0.f, 0.f, 0.f, 0.f};
    bf16x8 At[4][2], B0[2][2], B1[2][2];
    const char* cA = (const char*)g.A + (size_t)cur.pm * tstep; const char* cB = (const char*)g.Bt + (size_t)cur.pn * tstep;
    S.a_ready(cur);
    if constexpr (SP2) {
        PG8_STAGE(PG8_SB(0, 0), cB, voffB); PG8_STAGE(PG8_SB(0, 1), cB + hstep, voffB); PG8_STAGE(PG8_SA(0, 0), cA, voffA); PG8_STAGE(PG8_SA(0, 1), cA + hstep, voffA);
        if (wr == 1) PG8_BAR;
        PG8_WAIT_V(2); PG8_BAR;
        PG8_STAGE(PG8_SB(1, 0), cB + kstep, voffB); PG8_STAGE(PG8_SA(1, 0), cA + kstep, voffA); PG8_STAGE(PG8_SB(1, 1), cB + hstep + kstep, voffB);
        PG8_WAIT_V(6); PG8_BAR;
    } else {
        PG8_STAGE(PG8_SB(0, 0), cB, voffB); PG8_STAGE(PG8_SA(0, 0), cA, voffA); PG8_STAGE(PG8_SB(0, 1), cB + hstep, voffB); PG8_STAGE(PG8_SA(0, 1), cA + hstep, voffA);
        if (wr == 1) PG8_BAR;
        PG8_WAIT_V(4); PG8_BAR;
        PG8_STAGE(PG8_SB(1, 0), cB + kstep, voffB); PG8_STAGE(PG8_SA(1, 0), cA + kstep, voffA); PG8_STAGE(PG8_SB(1, 1), cB + hstep + kstep, voffB);
        PG8_WAIT_V(6); PG8_BAR;
    }
    for (;;) {
        const bool has_next = S.next(ui + 1, nxt);
        const char* nA = has_next ? (const char*)g.A + (size_t)nxt.pm * tstep : cA; const char* nB = has_next ? (const char*)g.Bt + (size_t)nxt.pn * tstep : cB;
        for (int t = 0; t < nt; t += 2) {
            const bool last = (t == nt - 2);
            const char* a1 = cA + (size_t)(t + 1) * kstep;
            const char* a2 = last ? nA : cA + (size_t)(t + 2) * kstep; const char* b2 = last ? nB : cB + (size_t)(t + 2) * kstep;
            const char* a3 = a2 + kstep; const char* b3 = b2 + kstep;
            if (last && has_next) S.a_ready(nxt);
            if constexpr (SP2) {
            PG8_LDB(B0, 0, 0); PG8_LDB(B1, 0, 1); PG8_SCHED; PG8_LDA(At, 0, 0); PG8_STAGE(PG8_SA(1, 1), a1 + hstep, voffA);
            PG8_WAIT_V(8); PG8_WAIT_L(0); PG8_BAR; PG8_MMA(0, 0, At, B0); PG8_MMA(0, 1, At, B1); PG8_BAR; PG8_SCHED;
            PG8_LDA(At, 0, 1); PG8_STAGE(PG8_SB(0, 0), b2, voffB); PG8_STAGE(PG8_SB(0, 1), b2 + hstep, voffB); PG8_STAGE(PG8_SA(0, 0), a2, voffA);
            PG8_WAIT_V(8); PG8_WAIT_L(0); PG8_BAR; PG8_MMA(1, 0, At, B0); PG8_MMA(1, 1, At, B1); PG8_BAR; PG8_SCHED;
            PG8_LDB(B0, 1, 0); PG8_LDB(B1, 1, 1); PG8_SCHED; PG8_LDA(At, 1, 0); PG8_STAGE(PG8_SA(0, 1), a2 + hstep, voffA);
            PG8_WAIT_V(8); PG8_WAIT_L(0); PG8_BAR; PG8_MMA(0, 0, At, B0); PG8_MMA(0, 1, At, B1); PG8_BAR; PG8_SCHED;
            PG8_LDA(At, 1, 1); PG8_STAGE(PG8_SB(1, 0), b3, voffB); PG8_STAGE(PG8_SB(1, 1), b3 + hstep, voffB); PG8_STAGE(PG8_SA(1, 0), a3, voffA);
            PG8_WAIT_V(8); PG8_WAIT_L(0); PG8_BAR; PG8_MMA(1, 0, At, B0); PG8_MMA(1, 1, At, B1); PG8_BAR; PG8_SCHED;
            } else {
            PG8_LDB(B0, 0, 0); PG8_SCHED; PG8_LDA(At, 0, 0); PG8_STAGE(PG8_SA(1, 1), a1 + hstep, voffA);
            PG8_WAIT_L(8); PG8_BAR; PG8_WAIT_L(0); PG8_MMA(0, 0, At, B0); PG8_BAR; PG8_SCHED;
            PG8_LDB(B1, 0, 1); PG8_STAGE(PG8_SB(0, 0), b2, voffB);
            PG8_BAR; PG8_WAIT_L(0); PG8_MMA(0, 1, At, B1); PG8_BAR;
            PG8_LDA(At, 0, 1); PG8_STAGE(PG8_SA(0, 0), a2, voffA);
            PG8_BAR; PG8_WAIT_L(0); PG8_MMA(1, 0, At, B0); PG8_BAR; PG8_SCHED;
            PG8_STAGE(PG8_SB(0, 1), b2 + hstep, voffB);
            PG8_WAIT_V(6); PG8_BAR; PG8_MMA(1, 1, At, B1); PG8_BAR;
            PG8_LDB(B0, 1, 0); PG8_SCHED; PG8_LDA(At, 1, 0); PG8_STAGE(PG8_SA(0, 1), a2 + hstep, voffA);
            PG8_WAIT_L(8); PG8_BAR; PG8_WAIT_L(0); PG8_MMA(0, 0, At, B0); PG8_BAR; PG8_SCHED;
            PG8_LDB(B1, 1, 1); PG8_STAGE(PG8_SB(1, 0), b3, voffB);
            PG8_BAR; PG8_WAIT_L(0); PG8_MMA(0, 1, At, B1); PG8_BAR;
            PG8_LDA(At, 1, 1); PG8_STAGE(PG8_SA(1, 0), a3, voffA);
            PG8_BAR; PG8_WAIT_L(0); PG8_MMA(1, 0, At, B0); PG8_BAR; PG8_SCHED;
            PG8_STAGE(PG8_SB(1, 1), b3 + hstep, voffB);
            PG8_WAIT_V(6); PG8_BAR; PG8_MMA(1, 1, At, B1); PG8_BAR;
            }
        }
        if constexpr (ALIGN_EPI) { if (wr == 0) PG8_BAR; }
        if constexpr (!Epi::AFTER_DRAIN) { E(acc, cur, wr, wc, fr, fq); S.done(cur); }
        if (!has_next) break;
#pragma unroll
        for (int a = 0; a < 2; ++a)
#pragma unroll
            for (int b = 0; b < 2; ++b)
#pragma unroll
                for (int m = 0; m < 4; ++m)
#pragma unroll
                    for (int n = 0; n < 2; ++n) acc[a][b][m][n] = (f32x4){0.f, 0.f, 0.f, 0.f};
        cur = nxt; cA = nA; cB = nB; ++ui;
        if constexpr (ALIGN_EPI) { if (wr == 1) PG8_BAR; }
    }
    PG8_WAIT_V(0);
    if constexpr (!ALIGN_EPI) { if (wr == 0) PG8_BAR; }
    PG8_BAR;
    if constexpr (Epi::AFTER_DRAIN) { E.fused(acc, cur, wr, wc, fr, fq, lds, wid, lane); S.done(cur); }
#undef PG8_SA
#undef PG8_SB
#undef PG8_STAGE
#undef PG8_LDA
#undef PG8_LDB
#undef PG8_MMA
#undef PG8_WAIT_V
#undef PG8_WAIT_L
#undef PG8_BAR
#undef PG8_SCHED
}
}
constexpr int NWAVES = 8, NTHR = NWAVES * 64;
constexpr int D = 1024, SEQ = 8192, NBATCH = 10, M = NBATCH * SEQ, MP = 2 * SEQ;
constexpr int DIN = 4608, DFF = 2816, NZ = 4096;
constexpr int ZQ = 1024, ZK = 1536, ZGP = 2048, ZGA = 3072;
constexpr int GRID_W = 64, GRID_H = SEQ / GRID_W;
constexpr float EPS = 1e-6f;
constexpr size_t MiB = 1u << 20;
constexpr size_t WS_W1 = 1 * MiB, WS_WV = 9 * MiB, WS_W2 = 11 * MiB, WS_W3 = 13 * MiB, WS_W4 = 24 * MiB, WS_PS = 30 * MiB;
constexpr size_t WS_XN = 36 * MiB;
constexpr size_t WS_Z = 196 * MiB;
constexpr size_t WS_H2 = WS_Z + 440 * MiB;
constexpr size_t WS_VT = 836 * MiB;
constexpr size_t WS_END = 996 * MiB;
static_assert(WS_W4 + (size_t)D * DFF * 2 <= WS_PS && WS_PS + (size_t)M * 16 * 4 <= WS_XN && WS_XN + (size_t)M * D * 2 <= WS_Z && WS_Z + (size_t)M * NZ * 2 <= WS_VT &&
              (size_t)M * DFF * 2 <= 440 * MiB && WS_H2 + (size_t)M * D * 2 <= WS_VT && WS_VT + (size_t)M * D * 2 <= WS_END, "d_ws map");
constexpr int PA_STRIDE = 2080;
constexpr int PA_BYTES = 64 * PA_STRIDE;
constexpr int RPB_N = 8 * 15 * 31;
constexpr int LDS_BYTES = 155648;
static_assert(PA_BYTES + RPB_N * 4 <= LDS_BYTES && pg8::STAGE_BYTES <= LDS_BYTES, "LDS map");

#define LAS __attribute__((address_space(3)))
typedef unsigned short bf16;
typedef float f32x4 __attribute__((ext_vector_type(4)));
typedef short bf16x8 __attribute__((ext_vector_type(8)));
typedef unsigned u32x2 __attribute__((ext_vector_type(2)));
typedef unsigned u32x4 __attribute__((ext_vector_type(4)));
#define LDS_WAIT() asm volatile("s_waitcnt lgkmcnt(0)" ::: "memory")
__device__ __forceinline__ unsigned f2bf(float f) { unsigned u = __builtin_bit_cast(unsigned, f); return (u + 0x7fffu + ((u >> 16) & 1u)) >> 16; }
__device__ __forceinline__ unsigned pk2(float lo, float hi) { return f2bf(lo) | (f2bf(hi) << 16); }
__device__ __forceinline__ float bflo(unsigned w) { return __uint_as_float(w << 16); }
__device__ __forceinline__ float bfhi(unsigned w) { return __uint_as_float(w & 0xffff0000u); }
__device__ __forceinline__ float sigm(float v) { return __builtin_amdgcn_rcpf(1.0f + __expf(-v)); }
__device__ __forceinline__ float wave_sum(float v) {
#pragma unroll
    for (int o = 1; o < 64; o <<= 1) v += __shfl_xor(v, o);
    return v;
}

struct Args { const float* in[13]; float* out; unsigned char* ws; int ph_lo, ph_hi; };
struct Ctx {
    LAS unsigned char* lds; int tid, lane, wave, vcu, G;
    const float *xp, *xs, *g_mix_pre, *w_in, *w_grp, *pool_scale, *rpb, *w_out, *g_mix_post, *g_ffn_pre, *w_gu, *w_down, *g_ffn_post;
    float* out; bf16 *W1t, *Wvt, *W2t, *W3t, *W4t, *XN, *Z, *VT, *MX, *T, *H2, *ACT, *FO; float* PS;
};
__device__ __forceinline__ const float* xrow(const Ctx& F, int m) { return m < MP ? F.xp + (size_t)m * D : F.xs + (size_t)(m - MP) * D; }

__device__ __forceinline__ void tr_item(const float* W, int ldw, int nsrc0, int k0, bf16* WT, int Kdst, int drow0, const float* gain, float mul, LAS float* scr, int lane) {
#pragma unroll 8
    for (int i = 0; i < 32; ++i) { const int kk = 2 * i + (lane >> 5); const float gsc = gain ? gain[k0 + kk] * mul : mul;
        scr[kk * 33 + (lane & 31)] = W[(size_t)(k0 + kk) * ldw + nsrc0 + (lane & 31)] * gsc; }
    LDS_WAIT(); asm volatile("" ::: "memory");
    const int c = lane & 7;
#pragma unroll
    for (int j = 0; j < 4; ++j) { const int n = (lane >> 3) + 8 * j; const LAS float* s = scr + (8 * c) * 33 + n;
        u32x4 o; o.x = pk2(s[0 * 33], s[1 * 33]); o.y = pk2(s[2 * 33], s[3 * 33]); o.z = pk2(s[4 * 33], s[5 * 33]); o.w = pk2(s[6 * 33], s[7 * 33]);
        *(u32x4*)(WT + (size_t)(drow0 + n) * Kdst + k0 + 8 * c) = o; }
    LDS_WAIT(); asm volatile("" ::: "memory");
}
__device__ __forceinline__ void tr_seg(const float* W, int ldw, int nsrc_base, int ncols, bf16* WT, int Kdst, int drow_base, const float* gain, float mul, LAS float* scr, int lane, int item) {
    const int nblk = ncols / 32, kb = item / nblk, nb = item % nblk;
    tr_item(W, ldw, nsrc_base + 32 * nb, 64 * kb, WT, Kdst, drow_base + 32 * nb, gain, mul, scr, lane);
}
__device__ __forceinline__ void fold_item(const Ctx& F, int item, int lane) {
    const int kb = item >> 7, nb = item & 127, grp = nb >> 5, d0 = (nb & 31) * 8, k = kb * 64 + lane;
    const float* a = F.w_in + (size_t)k * DIN + grp * 128; const float* bw = F.w_grp + (size_t)grp * 128 * 256 + d0;
    float acc[8];
#pragma unroll
    for (int e = 0; e < 8; ++e) acc[e] = 0.f;
    for (int c = 0; c < 128; c += 4) { const f32x4 av = *(const f32x4*)(a + c);
#pragma unroll
        for (int cc = 0; cc < 4; ++cc) { const f32x4 b0 = *(const f32x4*)(bw + (size_t)(c + cc) * 256), b1 = *(const f32x4*)(bw + (size_t)(c + cc) * 256 + 4);
            acc[0] += av[cc] * b0[0]; acc[1] += av[cc] * b0[1]; acc[2] += av[cc] * b0[2]; acc[3] += av[cc] * b0[3];
            acc[4] += av[cc] * b1[0]; acc[5] += av[cc] * b1[1]; acc[6] += av[cc] * b1[2]; acc[7] += av[cc] * b1[3]; } }
    const float gk = F.g_mix_pre[k];
#pragma unroll
    for (int e = 0; e < 8; ++e) { const int n = grp * 256 + d0 + e; F.W1t[(size_t)n * D + k] = (bf16)f2bf(acc[e] * gk * F.pool_scale[n]); }
}
__device__ __forceinline__ void rms_row_to_bf16(const float* xr_, bf16* orow, int lane) {
    const f32x4* xr = (const f32x4*)xr_ + lane;
    f32x4 v[4]; float s = 0.f;
#pragma unroll
    for (int j = 0; j < 4; ++j) { v[j] = xr[64 * j]; s += (v[j].x * v[j].x + v[j].y * v[j].y) + (v[j].z * v[j].z + v[j].w * v[j].w); }
    const float rstd = 1.0f / sqrtf(wave_sum(s) * (1.f / D) + EPS);
    unsigned long long* o8 = (unsigned long long*)orow + lane;
#pragma unroll
    for (int j = 0; j < 4; ++j) o8[64 * j] = (unsigned long long)pk2(v[j].x * rstd, v[j].y * rstd) | ((unsigned long long)pk2(v[j].z * rstd, v[j].w * rstd) << 32);
}
__device__ __forceinline__ void p0_prologue(const Ctx& F) {
    LAS float* scr = (LAS float*)(F.lds + F.wave * 16384);
    const int gw = F.vcu * NWAVES + F.wave, NGW = F.G * NWAVES, lane = F.lane;
    constexpr int I_Q = 16 * 16, I_K = 16 * 16, I_G = 16 * 64, I_V = 16 * 32, I_O = 16 * 32, I_GU = 16 * 176, I_DN = 44 * 32, I_FOLD = 16 * 128;
    constexpr int NITEMS = I_Q + I_K + I_G + I_V + I_O + I_GU + I_DN + I_FOLD;
    for (int it = gw; it < NITEMS; it += NGW) {
        int r = it;
        if (r < I_FOLD) { fold_item(F, r, lane); continue; } r -= I_FOLD;
        if (r < I_Q) { tr_seg(F.w_in, DIN, 512, 512, F.W1t, D, ZQ, F.g_mix_pre, 0.125f, scr, lane, r); continue; } r -= I_Q;
        if (r < I_K) { tr_seg(F.w_in, DIN, 1024, 512, F.W1t, D, ZK, F.g_mix_pre, 1.f, scr, lane, r); continue; } r -= I_K;
        if (r < I_G) { tr_seg(F.w_in, DIN, 2560, 2048, F.W1t, D, ZGP, F.g_mix_pre, 1.f, scr, lane, r); continue; } r -= I_G;
        if (r < I_V) { tr_seg(F.w_in, DIN, 1536, 1024, F.Wvt, D, 0, F.g_mix_pre, 1.f, scr, lane, r); continue; } r -= I_V;
        if (r < I_O) { tr_seg(F.w_out, D, 0, 1024, F.W2t, D, 0, nullptr, 1.f, scr, lane, r); continue; } r -= I_O;
        if (r < I_GU) {
            const int kb = r / 176, nb = r % 176, nsrc = 32 * nb, isup = nsrc >= DFF, nn = isup ? nsrc - DFF : nsrc;
            tr_item(F.w_gu, 2 * DFF, nsrc, 64 * kb, F.W3t, D, (nn >> 7) * 256 + (nn & 127) + (isup ? 128 : 0), F.g_ffn_pre, 1.f, scr, lane); continue; } r -= I_GU;
        tr_seg(F.w_down, D, 0, 1024, F.W4t, DFF, 0, nullptr, 1.f, scr, lane, r);
    }
    for (int m = gw; m < M; m += NGW) rms_row_to_bf16(xrow(F, m), F.XN + (size_t)m * D, lane);
}

__device__ __forceinline__ void mixer_phase(const Ctx& F) {
    LAS unsigned char* PA = F.lds; LAS float* rpbL = (LAS float*)(F.lds + PA_BYTES);
    for (int i = F.tid; i < RPB_N; i += NTHR) rpbL[i] = F.rpb[i];
    __syncthreads();
    const int tid = F.tid, lane = F.lane, h = F.wave, g = lane >> 4, li = lane & 15;
    for (int unit = F.vcu; unit < NBATCH * GRID_H; unit += F.G) {
        const int b = unit >> 7, r = unit & 127;
        const bf16* Zb = F.Z + (size_t)b * SEQ * NZ;
        {
            const int hw = 1 << (F.wave >> 1), s0 = r * GRID_W; const bf16* zc = Zb + 2 * tid;
            float sum0 = 0.f, sum1 = 0.f;
            for (int j = s0 - hw; j <= s0 + hw - 2; ++j) if (j >= 0 && j < SEQ) { const unsigned u = *(const unsigned*)(zc + (size_t)j * NZ); sum0 += bflo(u); sum1 += bfhi(u); }
#pragma unroll 4
            for (int c = 0; c < GRID_W; ++c) {
                const int s = s0 + c, ja = s + hw - 1, jr = s - hw;
                if (ja < SEQ) { const unsigned u = *(const unsigned*)(zc + (size_t)ja * NZ); sum0 += bflo(u); sum1 += bfhi(u); }
                const int lo = jr > 0 ? jr : 0, hi = (s + hw) < SEQ ? (s + hw) : SEQ; const float inv = 1.0f / (float)(hi - lo);
                const unsigned uc = *(const unsigned*)(zc + (size_t)s * NZ), gp = *(const unsigned*)(zc + (size_t)s * NZ + ZGP);
                const float o0 = (sum0 * inv - bflo(uc)) * sigm(bflo(gp)), o1 = (sum1 * inv - bfhi(uc)) * sigm(bfhi(gp));
                *(LAS unsigned*)(PA + c * PA_STRIDE + 4 * tid) = pk2(o0, o1);
                if (jr >= 0) { const unsigned u = *(const unsigned*)(zc + (size_t)jr * NZ); sum0 -= bflo(u); sum1 -= bfhi(u); }
            }
        }
        __syncthreads();
        const int rs = (r - 4) < 0 ? 0 : ((r - 4) > GRID_H - 8 ? GRID_H - 8 : (r - 4));
        for (int j = 0; j < 4; ++j) {
            const int kc0 = (j == 0) ? 0 : (j == 1) ? 8 : (j == 2) ? 24 : 32;
            const int c = 16 * j + li; const size_t qtok = (size_t)r * GRID_W + c;
            const bf16* qp = Zb + qtok * NZ + ZQ + h * 64 + 8 * g;
            const bf16x8 Q0 = *(const bf16x8*)qp, Q1 = *(const bf16x8*)(qp + 32);
            f32x4 sacc[8][2];
#pragma unroll
            for (int kr = 0; kr < 8; ++kr)
#pragma unroll
                for (int hf = 0; hf < 2; ++hf) {
                    const bf16* kp = Zb + ((size_t)(rs + kr) * GRID_W + kc0 + 16 * hf + li) * NZ + ZK + h * 64 + 8 * g;
                    const bf16x8 K0 = *(const bf16x8*)kp, K1 = *(const bf16x8*)(kp + 32);
                    f32x4 a = {0.f, 0.f, 0.f, 0.f};
                    a = __builtin_amdgcn_mfma_f32_16x16x32_bf16(K0, Q0, a, 0, 0, 0);
                    a = __builtin_amdgcn_mfma_f32_16x16x32_bf16(K1, Q1, a, 0, 0, 0);
                    sacc[kr][hf] = a;
                }
            const int cs = (c - 8) < 0 ? 0 : ((c - 8) > GRID_W - 16 ? GRID_W - 16 : (c - 8));
            float mx = -INFINITY;
#pragma unroll
            for (int kr = 0; kr < 8; ++kr) { const LAS float* rp = rpbL + h * 465 + (rs + kr - r + 7) * 31 + 15;
#pragma unroll
                for (int hf = 0; hf < 2; ++hf)
#pragma unroll
                    for (int i = 0; i < 4; ++i) { const int kc = kc0 + 16 * hf + 4 * g + i; int dc = kc - c; const bool valid = (kc >= cs) && (kc < cs + 16);
                        dc = dc < -15 ? -15 : (dc > 15 ? 15 : dc);
                        const float sv = valid ? sacc[kr][hf][i] + rp[dc] : -INFINITY; sacc[kr][hf][i] = sv; mx = fmaxf(mx, sv); } }
            mx = fmaxf(mx, __shfl_xor(mx, 16)); mx = fmaxf(mx, __shfl_xor(mx, 32));
            float sum = 0.f; bf16x8 Pf[8];
#pragma unroll
            for (int kr = 0; kr < 8; ++kr) { float p[8];
#pragma unroll
                for (int hf = 0; hf < 2; ++hf)
#pragma unroll
                    for (int i = 0; i < 4; ++i) { const float pv = __expf(sacc[kr][hf][i] - mx); p[4 * hf + i] = pv; sum += pv; }
                u32x4 w; w.x = pg8::cvt_pk_bf16(p[0], p[1]); w.y = pg8::cvt_pk_bf16(p[2], p[3]); w.z = pg8::cvt_pk_bf16(p[4], p[5]); w.w = pg8::cvt_pk_bf16(p[6], p[7]);
                Pf[kr] = __builtin_bit_cast(bf16x8, w); }
            sum += __shfl_xor(sum, 16); sum += __shfl_xor(sum, 32);
            const float inv = 1.0f / sum;
            f32x4 oacc[8];
#pragma unroll
            for (int nb = 0; nb < 8; ++nb) oacc[nb] = (f32x4){0.f, 0.f, 0.f, 0.f};
#pragma unroll
            for (int kr = 0; kr < 8; ++kr) { const size_t tokb = (size_t)b * SEQ + (size_t)(rs + kr) * GRID_W + kc0 + 4 * g;
#pragma unroll
                for (int nb = 0; nb < 8; ++nb) { const bf16* vp = F.VT + (size_t)(h * 128 + nb * 16 + li) * M + tokb;
                    const u32x2 lo = *(const u32x2*)vp, hi = *(const u32x2*)(vp + 16);
                    const u32x4 w = {lo.x, lo.y, hi.x, hi.y};
                    oacc[nb] = __builtin_amdgcn_mfma_f32_16x16x32_bf16(__builtin_bit_cast(bf16x8, w), Pf[kr], oacc[nb], 0, 0, 0); } }
            const bf16* gap = Zb + qtok * NZ + ZGA + h * 128 + 4 * g; bf16* mp = F.MX + ((size_t)b * SEQ + qtok) * D + h * 128 + 4 * g;
            const LAS unsigned char* pap = PA + (16 * j + li) * PA_STRIDE + (h * 128 + 4 * g) * 2;
#pragma unroll
            for (int nb = 0; nb < 8; ++nb) { const u32x2 ga = *(const u32x2*)(gap + nb * 16); const u32x2 pa = *(const LAS u32x2*)(pap + nb * 32);
                const float o0 = bflo(pa.x) + sigm(bflo(ga.x)) * oacc[nb][0] * inv, o1 = bfhi(pa.x) + sigm(bfhi(ga.x)) * oacc[nb][1] * inv;
                const float o2 = bflo(pa.y) + sigm(bflo(ga.y)) * oacc[nb][2] * inv, o3 = bfhi(pa.y) + sigm(bfhi(ga.y)) * oacc[nb][3] * inv;
                u32x2 w; w.x = pg8::cvt_pk_bf16(o0, o1); w.y = pg8::cvt_pk_bf16(o2, o3); *(u32x2*)(mp + nb * 16) = w; }
        }
        __syncthreads();
    }
}

template <bool SECOND> __device__ __forceinline__ void norm_rows(const Ctx& F) {
    const int gw = F.vcu * NWAVES + F.wave, NGW = F.G * NWAVES, lane = F.lane;
    const float* gpost = SECOND ? F.g_ffn_post : F.g_mix_post; const bf16* Tb = SECOND ? F.FO : F.T;
    f32x4 gv[4];
#pragma unroll
    for (int j = 0; j < 4; ++j) gv[j] = ((const f32x4*)gpost)[64 * j + lane];
    for (int m = gw; m < M; m += NGW) {
        float ss = F.PS[(size_t)m * 16 + (lane & 15)];
        ss += __shfl_xor(ss, 1); ss += __shfl_xor(ss, 2); ss += __shfl_xor(ss, 4); ss += __shfl_xor(ss, 8);
        const float rstdT = 1.0f / sqrtf(ss * (1.f / D) + EPS);
        const f32x4* xr = (const f32x4*)(SECOND ? F.out + (size_t)m * D : xrow(F, m)) + lane;
        const u32x2* tr = (const u32x2*)(Tb + (size_t)m * D) + lane;
        f32x4 v[4]; float s2 = 0.f;
#pragma unroll
        for (int j = 0; j < 4; ++j) { const f32x4 xv = xr[64 * j]; const u32x2 t = tr[64 * j];
            v[j].x = xv.x + bflo(t.x) * rstdT * gv[j].x; v[j].y = xv.y + bfhi(t.x) * rstdT * gv[j].y; v[j].z = xv.z + bflo(t.y) * rstdT * gv[j].z; v[j].w = xv.w + bfhi(t.y) * rstdT * gv[j].w;
            s2 += (v[j].x * v[j].x + v[j].y * v[j].y) + (v[j].z * v[j].z + v[j].w * v[j].w); }
        f32x4* orow = (f32x4*)(F.out + (size_t)m * D) + lane;
#pragma unroll
        for (int j = 0; j < 4; ++j) orow[64 * j] = v[j];
        if (!SECOND) {
            const float rstd = 1.0f / sqrtf(wave_sum(s2) * (1.f / D) + EPS);
            unsigned long long* o8 = (unsigned long long*)(F.H2 + (size_t)m * D) + lane;
#pragma unroll
            for (int j = 0; j < 4; ++j) o8[64 * j] = (unsigned long long)pk2(v[j].x * rstd, v[j].y * rstd) | ((unsigned long long)pk2(v[j].z * rstd, v[j].w * rstd) << 32);
        }
    }
}

__global__ void __launch_bounds__(NTHR, 2) enc_fwd(Args args) {
    extern __shared__ __attribute__((aligned(16))) unsigned char lds[];
    cg::grid_group grid = cg::this_grid();
    Ctx F;
    F.lds = (LAS unsigned char*)lds;
    F.tid = threadIdx.x; F.lane = F.tid & 63; F.wave = __builtin_amdgcn_readfirstlane(F.tid >> 6);
    F.G = gridDim.x; { const int bx = blockIdx.x; F.vcu = (F.G % 8 == 0) ? (bx % 8) * (F.G / 8) + bx / 8 : bx; }
    unsigned char* ws = args.ws;
    F.xp = args.in[0]; F.xs = args.in[1]; F.g_mix_pre = args.in[2]; F.w_in = args.in[3]; F.w_grp = args.in[4]; F.pool_scale = args.in[5]; F.rpb = args.in[6]; F.w_out = args.in[7];
    F.g_mix_post = args.in[8]; F.g_ffn_pre = args.in[9]; F.w_gu = args.in[10]; F.w_down = args.in[11]; F.g_ffn_post = args.in[12]; F.out = args.out;
    F.W1t = (bf16*)(ws + WS_W1); F.Wvt = (bf16*)(ws + WS_WV); F.W2t = (bf16*)(ws + WS_W2); F.W3t = (bf16*)(ws + WS_W3); F.W4t = (bf16*)(ws + WS_W4); F.PS = (float*)(ws + WS_PS);
    F.XN = (bf16*)(ws + WS_XN); F.MX = F.XN; F.FO = F.XN; F.Z = (bf16*)(ws + WS_Z); F.ACT = F.Z; F.H2 = (bf16*)(ws + WS_H2); F.VT = (bf16*)(ws + WS_VT); F.T = F.VT;
    const int lo = args.ph_lo, hi = args.ph_hi;
#define IN(k) (lo <= (k) && (k) < hi)
#define SEAM(k) do { if (IN(k) && IN((k) + 1)) grid.sync(); } while (0)
    if (IN(0)) { p0_prologue(F); } SEAM(0);
    if (IN(1)) {
        { pg8::Gemm g{F.XN, F.W1t, M, NZ, D}; pg8::StaticOrder S; S.init(M, NZ, F.G, (int)blockIdx.x); pg8::EpiPlain E{F.Z, NZ};
          pg8::gemm_phase<pg8::EpiPlain, pg8::StaticOrder, true, true>(F.lds, g, S, E); }
        { pg8::Gemm g{F.Wvt, F.XN, D, M, D}; pg8::StaticOrder S; S.init(D, M, F.G, (int)blockIdx.x); pg8::EpiPlain E{F.VT, M};
          pg8::gemm_phase<pg8::EpiPlain, pg8::StaticOrder, true, true>(F.lds, g, S, E); }
    } SEAM(1);
    if (IN(2)) { mixer_phase(F); } SEAM(2);
    if (IN(3)) { pg8::Gemm g{F.MX, F.W2t, M, D, D}; pg8::StaticOrder S; S.init(M, D, F.G, (int)blockIdx.x); pg8::EpiSumsq E{F.T, D, F.PS};
        pg8::gemm_phase<pg8::EpiSumsq, pg8::StaticOrder, true, true>(F.lds, g, S, E); } SEAM(3);
    if (IN(4)) { norm_rows<false>(F); } SEAM(4);
    if (IN(5)) { pg8::Gemm g{F.H2, F.W3t, M, 2 * DFF, D}; pg8::StaticOrder S; S.init(M, 2 * DFF, F.G, (int)blockIdx.x); pg8::EpiSwiglu E{F.ACT, DFF};
        pg8::gemm_phase<pg8::EpiSwiglu, pg8::StaticOrder, true, true>(F.lds, g, S, E); } SEAM(5);
    if (IN(6)) { pg8::Gemm g{F.ACT, F.W4t, M, D, DFF}; pg8::StaticOrder S; S.init(M, D, F.G, (int)blockIdx.x); pg8::EpiSumsq E{F.FO, D, F.PS};
        pg8::gemm_phase<pg8::EpiSumsq, pg8::StaticOrder, true, true>(F.lds, g, S, E); } SEAM(6);
    if (IN(7)) { norm_rows<true>(F); }
#undef IN
#undef SEAM
}

#ifndef MK_PER_PHASE
#define MK_PER_PHASE 0
#endif
extern "C" void kernel_launch(void* const* d_in, const int* in_sizes, int n_in, void* d_out, int out_size, void* d_ws, size_t ws_size, hipStream_t stream) {
    static int grid = 0;
    if (grid == 0) {
        if (n_in != 13 || out_size != M * D || ws_size < WS_END) { fprintf(stderr, "kernel_launch: unexpected problem (n_in %d, out %d, ws %zu); nothing launched\n", n_in, out_size, ws_size); grid = -1; return; }
        int dev = 0, cus = 0, per_cu = 0;
        if (hipGetDevice(&dev) != hipSuccess || hipDeviceGetAttribute(&cus, hipDeviceAttributeMultiprocessorCount, dev) != hipSuccess) { grid = -1; return; }
        if (hipFuncSetAttribute((const void*)enc_fwd, hipFuncAttributeMaxDynamicSharedMemorySize, LDS_BYTES) != hipSuccess) { fprintf(stderr, "kernel_launch: hipFuncSetAttribute failed\n"); grid = -1; return; }
        if (hipOccupancyMaxActiveBlocksPerMultiprocessor(&per_cu, (const void*)enc_fwd, NTHR, LDS_BYTES) != hipSuccess || per_cu < 1) { fprintf(stderr, "kernel_launch: occupancy query says %d\n", per_cu); per_cu = 1; }
        (void)hipGetLastError();
        grid = cus;
    }
    if (grid < 0) return;
    Args a{};
    for (int i = 0; i < 13; ++i) a.in[i] = (const float*)d_in[i];
    a.out = (float*)d_out; a.ws = (unsigned char*)d_ws;
#if MK_PER_PHASE
    for (int p = 0; p < 8; ++p) { a.ph_lo = p; a.ph_hi = p + 1; hipLaunchKernelGGL(enc_fwd, dim3(grid), dim3(NTHR), LDS_BYTES, stream, a); }
#else
    a.ph_lo = 0; a.ph_hi = 8;
    void* kargs[] = {&a};
    const hipError_t e = hipLaunchCooperativeKernel((const void*)enc_fwd, dim3(grid), dim3(NTHR), kargs, LDS_BYTES, stream);
    if (e != hipSuccess) fprintf(stderr, "kernel_launch: cooperative launch failed: %s (grid %d)\n", hipGetErrorString(e), grid);
#endif
}
```

```cpp
#include <hip/hip_runtime.h>
#include <hip/hip_cooperative_groups.h>
#include <cstdio>
#include <cstdint>
namespace cg = cooperative_groups;
namespace pg8 {
#define PG8_LAS __attribute__((address_space(3)))
typedef unsigned short bf16_t;
typedef short bf16x8 __attribute__((ext_vector_type(8)));
typedef float f32x4 __attribute__((ext_vector_type(4)));
typedef unsigned u32x4 __attribute__((ext_vector_type(4)));
constexpr int BM = 256, BK = 64, HALF = 128, HTB = HALF * BK * 2  , STAGE_BYTES = 8 * HTB, NXCD = 8, WGM = 8;

__host__ __device__ __forceinline__ int lds_byte(int r, int c) { const int st = (r >> 4) * 2 + (c >> 5), rr = r & 15, cc = c & 31, ob = rr * 64 + cc * 2; return st * 1024 + (ob ^ (((ob >> 9) & 1) << 5)); }
__host__ __device__ __forceinline__ void stage_rc(int b, int& R, int& C) { const int st = b / 1024, sb = b % 1024, swz = sb ^ (((sb >> 9) & 1) << 5); R = (st >> 1) * 16 + swz / 64; C = (st & 1) * 32 + (swz % 64) / 2; }
__host__ __device__ __forceinline__ int perm32(int rho) { const int n = rho >> 4, i = rho & 15; return 8 * (i >> 2) + 4 * n + (i & 3); }

struct Unit { int pm, pn; };
struct Gemm { const bf16_t* A; const bf16_t* Bt; int M, N, K; };

struct StaticOrder {
    int nM, nN, nwg, G, c;
    __host__ __device__ void init(int M, int N, int G_, int c_) { nM = M / BM; nN = N / BM; nwg = nM * nN; G = G_; c = c_; }
    __host__ __device__ bool next(int i, Unit& u) const {
        const long L = (long)i * G + c; if (L >= nwg) return false;
        int wgid = (int)L; { const int q = nwg / NXCD, r = nwg % NXCD, xcd = wgid % NXCD, off = wgid / NXCD; wgid = (xcd < r ? xcd * (q + 1) : r * (q + 1) + (xcd - r) * q) + off; }
        const int nig = WGM * nN, gid = wgid / nig, fm = gid * WGM, gsz = (nM - fm) < WGM ? (nM - fm) : WGM;
        u.pm = fm + ((wgid % nig) % gsz); u.pn = (wgid % nig) / gsz; return true;
    }
    __device__ __forceinline__ void a_ready(const Unit&) const {}
    __device__ __forceinline__ void done(const Unit&) const {}
};

__device__ __forceinline__ unsigned cvt_pk_bf16(float lo, float hi) { unsigned r; asm volatile("v_cvt_pk_bf16_f32 %0, %1, %2" : "=v"(r) : "v"(lo), "v"(hi)); return r; }
typedef float f32x2 __attribute__((ext_vector_type(2)));
__device__ __forceinline__ float fast_sigmoid(float v) { return __builtin_amdgcn_rcpf(1.0f + __expf(-v)); }
struct EpiPlain {
    static constexpr bool PERM = true, AFTER_DRAIN = false;
    bf16_t* O; int ldc;
    __device__ __forceinline__ void operator()(const f32x4 (&acc)[2][2][4][2], const Unit& u, int wr, int wc, int fr, int fq) const {
        const int row0 = u.pm * BM + wr * 64 + fr, col0 = u.pn * BM + wc * 32 + 8 * fq;
#pragma unroll
        for (int ai = 0; ai < 2; ++ai)
#pragma unroll
            for (int m = 0; m < 4; ++m) { bf16_t* rowp = O + (size_t)(row0 + ai * HALF + m * 16) * ldc + col0;
#pragma unroll
                for (int bj = 0; bj < 2; ++bj) { const f32x4 v0 = acc[ai][bj][m][0], v1 = acc[ai][bj][m][1];
                    u32x4 w; w.x = cvt_pk_bf16(v0[0], v0[1]); w.y = cvt_pk_bf16(v0[2], v0[3]); w.z = cvt_pk_bf16(v1[0], v1[1]); w.w = cvt_pk_bf16(v1[2], v1[3]);
                    *(u32x4*)(rowp + bj * HALF) = w; } }
    }
};
struct EpiSumsq {
    static constexpr bool PERM = true, AFTER_DRAIN = false;
    bf16_t* O; int ldc; float* ps;
    __device__ __forceinline__ void operator()(const f32x4 (&acc)[2][2][4][2], const Unit& u, int wr, int wc, int fr, int fq) const {
        const int row0 = u.pm * BM + wr * 64 + fr, col0 = u.pn * BM + wc * 32 + 8 * fq;
#pragma unroll
        for (int ai = 0; ai < 2; ++ai)
#pragma unroll
            for (int m = 0; m < 4; ++m) { const int row = row0 + ai * HALF + m * 16; bf16_t* rowp = O + (size_t)row * ldc + col0; float s = 0.f;
#pragma unroll
                for (int bj = 0; bj < 2; ++bj) { const f32x4 v0 = acc[ai][bj][m][0], v1 = acc[ai][bj][m][1];
                    s += (v0[0] * v0[0] + v0[1] * v0[1]) + (v0[2] * v0[2] + v0[3] * v0[3]) + (v1[0] * v1[0] + v1[1] * v1[1]) + (v1[2] * v1[2] + v1[3] * v1[3]);
                    u32x4 w; w.x = cvt_pk_bf16(v0[0], v0[1]); w.y = cvt_pk_bf16(v0[2], v0[3]); w.z = cvt_pk_bf16(v1[0], v1[1]); w.w = cvt_pk_bf16(v1[2], v1[3]);
                    *(u32x4*)(rowp + bj * HALF) = w; }
                s += __shfl_xor(s, 16); s += __shfl_xor(s, 32);
                if (fq == 0) ps[(size_t)row * 16 + u.pn * 4 + wc] = s; }
    }
};
struct EpiSwiglu {
    static constexpr bool PERM = true, AFTER_DRAIN = false;
    bf16_t* O; int ldc;
    __device__ __forceinline__ void operator()(const f32x4 (&acc)[2][2][4][2], const Unit& u, int wr, int wc, int fr, int fq) const {
        const int row0 = u.pm * BM + wr * 64 + fr, col0 = u.pn * HALF + wc * 32 + 8 * fq;
#pragma unroll
        for (int ai = 0; ai < 2; ++ai)
#pragma unroll
            for (int m = 0; m < 4; ++m) { bf16_t* rowp = O + (size_t)(row0 + ai * HALF + m * 16) * ldc + col0;
                float a[8];
#pragma unroll
                for (int n = 0; n < 2; ++n)
#pragma unroll
                    for (int e = 0; e < 4; ++e) { const float gt = acc[ai][0][m][n][e], up = acc[ai][1][m][n][e]; a[4 * n + e] = gt * fast_sigmoid(gt) * up; }
                u32x4 w; w.x = cvt_pk_bf16(a[0], a[1]); w.y = cvt_pk_bf16(a[2], a[3]); w.z = cvt_pk_bf16(a[4], a[5]); w.w = cvt_pk_bf16(a[6], a[7]);
                *(u32x4*)rowp = w; }
    }
};
template <class Epi, class Sched, bool ALIGN_EPI = false, bool SP2 = false>
__device__ __forceinline__ void gemm_phase(PG8_LAS unsigned char* lds, const Gemm g, const Sched& S, const Epi& E) {
    const int tid = threadIdx.x, wid = __builtin_amdgcn_readfirstlane(tid >> 6), lane = tid & 63, wr = wid >> 2, wc = wid & 3, fr = lane & 15, fq = lane >> 4;
    const int K = g.K, nt = K / BK;
    unsigned voffA[2], voffB[2];
#pragma unroll
    for (int i = 0; i < 2; ++i) { int R, C; stage_rc(tid * 16 + i * 8192, R, C); const int Rb = Epi::PERM ? ((R & ~31) + perm32(R & 31)) : R;
        voffA[i] = (unsigned)(R * K + C) * 2u; voffB[i] = (unsigned)(Rb * K + C) * 2u; }
    const size_t kstep = (size_t)(BK * 2);
    const size_t hstep = (size_t)HALF * K * 2;
    const size_t tstep = 2 * hstep;
    const unsigned ldsw = (unsigned)wid * 1024u;
    const int aoff = lds_byte(wr * 64 + fr, fq * 8), boff = lds_byte(wc * 32 + fr, fq * 8);
#define PG8_SA(b, h) (((b) * 2 + (h)) * HTB)
#define PG8_SB(b, h) ((4 + (b) * 2 + (h)) * HTB)
#define PG8_STAGE(bufoff, gbase, voff) do { _Pragma("unroll") for (int _i = 0; _i < 2; ++_i) \
        __builtin_amdgcn_global_load_lds((const unsigned*)((const char*)(gbase) + (voff)[_i]), (PG8_LAS unsigned*)(lds + (bufoff) + ldsw + _i * 8192), 16, 0, 0); } while (0)
#define PG8_LDA(dst, b, h) do { _Pragma("unroll") for (int m = 0; m < 4; ++m) _Pragma("unroll") for (int k = 0; k < 2; ++k) dst[m][k] = *(const PG8_LAS bf16x8*)(lds + PG8_SA(b, h) + aoff + m * 2048 + k * 1024); } while (0)
#define PG8_LDB(dst, b, h) do { _Pragma("unroll") for (int n = 0; n < 2; ++n) _Pragma("unroll") for (int k = 0; k < 2; ++k) dst[n][k] = *(const PG8_LAS bf16x8*)(lds + PG8_SB(b, h) + boff + n * 2048 + k * 1024); } while (0)
#define PG8_MMA(ai, bj, At, Bt) do { __builtin_amdgcn_s_setprio(1); _Pragma("unroll") for (int m = 0; m < 4; ++m) _Pragma("unroll") for (int n = 0; n < 2; ++n) _Pragma("unroll") for (int k = 0; k < 2; ++k) \
        acc[ai][bj][m][n] = __builtin_amdgcn_mfma_f32_16x16x32_bf16(Bt[n][k], At[m][k], acc[ai][bj][m][n], 0, 0, 0); __builtin_amdgcn_s_setprio(0); } while (0)
#define PG8_WAIT_V(n) asm volatile("s_waitcnt vmcnt(" #n ")" ::: "memory")
#define PG8_WAIT_L(n) asm volatile("s_waitcnt lgkmcnt(" #n ")" ::: "memory")
#define PG8_BAR __builtin_amdgcn_s_barrier()
#define PG8_SCHED __builtin_amdgcn_sched_barrier(0)
    Unit cur, nxt; int ui = 0;
    if (!S.next(0, cur)) return;
    f32x4 acc[2][2][4][2];
#pragma unroll
    for (int a = 0; a < 2; ++a)
#pragma unroll
        for (int b = 0; b < 2; ++b)
#pragma unroll
            for (int m = 0; m < 4; ++m)
#pragma unroll
                for (int n = 0; n < 2; ++n) acc[a][b][m][n] = (f32x4){0.f, 0.f, 0.f, 0.f};
    bf16x8 At[4][2], B0[2][2], B1[2][2];
    const char* cA = (const char*)g.A + (size_t)cur.pm * tstep; const char* cB = (const char*)g.Bt + (size_t)cur.pn * tstep;
    S.a_ready(cur);
    if constexpr (SP2) {
        PG8_STAGE(PG8_SB(0, 0), cB, voffB); PG8_STAGE(PG8_SB(0, 1), cB + hstep, voffB); PG8_STAGE(PG8_SA(0, 0), cA, voffA); PG8_STAGE(PG8_SA(0, 1), cA + hstep, voffA);
        if (wr == 1) PG8_BAR;
        PG8_WAIT_V(2); PG8_BAR;
        PG8_STAGE(PG8_SB(1, 0), cB + kstep, voffB); PG8_STAGE(PG8_SA(1, 0), cA + kstep, voffA); PG8_STAGE(PG8_SB(1, 1), cB + hstep + kstep, voffB);
        PG8_WAIT_V(6); PG8_BAR;
    } else {
        PG8_STAGE(PG8_SB(0, 0), cB, voffB); PG8_STAGE(PG8_SA(0, 0), cA, voffA); PG8_STAGE(PG8_SB(0, 1), cB + hstep, voffB); PG8_STAGE(PG8_SA(0, 1), cA + hstep, voffA);
        if (wr == 1) PG8_BAR;
        PG8_WAIT_V(4); PG8_BAR;
        PG8_STAGE(PG8_SB(1, 0), cB + kstep, voffB); PG8_STAGE(PG8_SA(1, 0), cA + kstep, voffA); PG8_STAGE(PG8_SB(1, 1), cB + hstep + kstep, voffB);
        PG8_WAIT_V(6); PG8_BAR;
    }
    for (;;) {
        const bool has_next = S.next(ui + 1, nxt);
        const char* nA = has_next ? (const char*)g.A + (size_t)nxt.pm * tstep : cA; const char* nB = has_next ? (const char*)g.Bt + (size_t)nxt.pn * tstep : cB;
        for (int t = 0; t < nt; t += 2) {
            const bool last = (t == nt - 2);
            const char* a1 = cA + (size_t)(t + 1) * kstep;
            const char* a2 = last ? nA : cA + (size_t)(t + 2) * kstep; const char* b2 = last ? nB : cB + (size_t)(t + 2) * kstep;
            const char* a3 = a2 + kstep; const char* b3 = b2 + kstep;
            if (last && has_next) S.a_ready(nxt);
            if constexpr (SP2) {
            PG8_LDB(B0, 0, 0); PG8_LDB(B1, 0, 1); PG8_SCHED; PG8_LDA(At, 0, 0); PG8_STAGE(PG8_SA(1, 1), a1 + hstep, voffA);
            PG8_WAIT_V(8); PG8_WAIT_L(0); PG8_BAR; PG8_MMA(0, 0, At, B0); PG8_MMA(0, 1, At, B1); PG8_BAR; PG8_SCHED;
            PG8_LDA(At, 0, 1); PG8_STAGE(PG8_SB(0, 0), b2, voffB); PG8_STAGE(PG8_SB(0, 1), b2 + hstep, voffB); PG8_STAGE(PG8_SA(0, 0), a2, voffA);
            PG8_WAIT_V(8); PG8_WAIT_L(0); PG8_BAR; PG8_MMA(1, 0, At, B0); PG8_MMA(1, 1, At, B1); PG8_BAR; PG8_SCHED;
            PG8_LDB(B0, 1, 0); PG8_LDB(B1, 1, 1); PG8_SCHED; PG8_LDA(At, 1, 0); PG8_STAGE(PG8_SA(0, 1), a2 + hstep, voffA);
            PG8_WAIT_V(8); PG8_WAIT_L(0); PG8_BAR; PG8_MMA(0, 0, At, B0); PG8_MMA(0, 1, At, B1); PG8_BAR; PG8_SCHED;
            PG8_LDA(At, 1, 1); PG8_STAGE(PG8_SB(1, 0), b3, voffB); PG8_STAGE(PG8_SB(1, 1), b3 + hstep, voffB); PG8_STAGE(PG8_SA(1, 0), a3, voffA);
            PG8_WAIT_V(8); PG8_WAIT_L(0); PG8_BAR; PG8_MMA(1, 0, At, B0); PG8_MMA(1, 1, At, B1); PG8_BAR; PG8_SCHED;
            } else {
            PG8_LDB(B0, 0, 0); PG8_SCHED; PG8_LDA(At, 0, 0); PG8_STAGE(PG8_SA(1, 1), a1 + hstep, voffA);
            PG8_WAIT_L(8); PG8_BAR; PG8_WAIT_L(0); PG8_MMA(0, 0, At, B0); PG8_BAR; PG8_SCHED;
            PG8_LDB(B1, 0, 1); PG8_STAGE(PG8_SB(0, 0), b2, voffB);
            PG8_BAR; PG8_WAIT_L(0); PG8_MMA(0, 1, At, B1); PG8_BAR;
            PG8_LDA(At, 0, 1); PG8_STAGE(PG8_SA(0, 0), a2, voffA);
            PG8_BAR; PG8_WAIT_L(0); PG8_MMA(1, 0, At, B0); PG8_BAR; PG8_SCHED;
            PG8_STAGE(PG8_SB(0, 1), b2 + hstep, voffB);
            PG8_WAIT_V(6); PG8_BAR; PG8_MMA(1, 1, At, B1); PG8_BAR;
            PG8_LDB(B0, 1, 0); PG8_SCHED; PG8_LDA(At, 1, 0); PG8_STAGE(PG8_SA(0, 1), a2 + hstep, voffA);
            PG8_WAIT_L(8); PG8_BAR; PG8_WAIT_L(0); PG8_MMA(0, 0, At, B0); PG8_BAR; PG8_SCHED;
            PG8_LDB(B1, 1, 1); PG8_STAGE(PG8_SB(1, 0), b3, voffB);
            PG8_BAR; PG8_WAIT_L(0); PG8_MMA(0, 1, At, B1); PG8_BAR;
            PG8_LDA(At, 1, 1); PG8_STAGE(PG8_SA(1, 0), a3, voffA);
            PG8_BAR; PG8_WAIT_L(0); PG8_MMA(1, 0, At, B0); PG8_BAR; PG8_SCHED;
            PG8_STAGE(PG8_SB(1, 1), b3 + hstep, voffB);
            PG8_WAIT_V(6); PG8_BAR; PG8_MMA(1, 1, At, B1); PG8_BAR;
            }
        }
        if constexpr (ALIGN_EPI) { if (wr == 0) PG8_BAR; }
        if constexpr (!Epi::AFTER_DRAIN) { E(acc, cur, wr, wc, fr, fq); S.done(cur); }
        if (!has_next) break;
#pragma unroll
        for (int a = 0; a < 2; ++a)
#pragma unroll
            for (int b = 0; b < 2; ++b)
#pragma unroll
                for (int m = 0; m < 4; ++m)
#pragma unroll
                    for (int n = 0; n < 2; ++n) acc[a][b][m][n] = (f32x4){0.f, 0.f, 0.f, 0.f};
        cur = nxt; cA = nA; cB = nB; ++ui;
        if constexpr (ALIGN_EPI) { if (wr == 1) PG8_BAR; }
    }
    PG8_WAIT_V(0);
    if constexpr (!ALIGN_EPI) { if (wr == 0) PG8_BAR; }
    PG8_BAR;
    if constexpr (Epi::AFTER_DRAIN) { E.fused(acc, cur, wr, wc, fr, fq, lds, wid, lane); S.done(cur); }
#undef PG8_SA
#undef PG8_SB
#undef PG8_STAGE
#undef PG8_LDA
#undef PG8_LDB
#undef PG8_MMA
#undef PG8_WAIT_V
#undef PG8_WAIT_L
#undef PG8_BAR
#undef PG8_SCHED
}
}
constexpr int NWAVES = 8, NTHR = NWAVES * 64;
constexpr int D = 1024, SEQ = 8192, NBATCH = 10, M = NBATCH * SEQ, MP = 2 * SEQ;
constexpr int DIN = 4608, DFF = 2816, NZ = 4096;
constexpr int ZQ = 1024, ZK = 1536, ZGP = 2048, ZGA = 3072;
constexpr int GRID_W = 64, GRID_H = SEQ / GRID_W;
constexpr float EPS = 1e-6f;
constexpr size_t MiB = 1u << 20;
constexpr size_t WS_W1 = 1 * MiB, WS_WV = 9 * MiB, WS_W2 = 11 * MiB, WS_W3 = 13 * MiB, WS_W4 = 24 * MiB, WS_PS = 30 * MiB;
constexpr size_t WS_XN = 36 * MiB;
constexpr size_t WS_Z = 196 * MiB;
constexpr size_t WS_H2 = WS_Z + 440 * MiB;
constexpr size_t WS_VT = 836 * MiB;
constexpr size_t WS_END = 996 * MiB;
static_assert(WS_W4 + (size_t)D * DFF * 2 <= WS_PS && WS_PS + (size_t)M * 16 * 4 <= WS_XN && WS_XN + (size_t)M * D * 2 <= WS_Z && WS_Z + (size_t)M * NZ * 2 <= WS_VT &&
              (size_t)M * DFF * 2 <= 440 * MiB && WS_H2 + (size_t)M * D * 2 <= WS_VT && WS_VT + (size_t)M * D * 2 <= WS_END, "d_ws map");
constexpr int PA_STRIDE = 2080;
constexpr int PA_BYTES = 64 * PA_STRIDE;
constexpr int RPB_N = 8 * 15 * 31;
constexpr int LDS_BYTES = 155648;
static_assert(PA_BYTES + RPB_N * 4 <= LDS_BYTES && pg8::STAGE_BYTES <= LDS_BYTES, "LDS map");

#define LAS __attribute__((address_space(3)))
typedef unsigned short bf16;
typedef float f32x4 __attribute__((ext_vector_type(4)));
typedef short bf16x8 __attribute__((ext_vector_type(8)));
typedef unsigned u32x2 __attribute__((ext_vector_type(2)));
typedef unsigned u32x4 __attribute__((ext_vector_type(4)));
#define LDS_WAIT() asm volatile("s_waitcnt lgkmcnt(0)" ::: "memory")
__device__ __forceinline__ unsigned f2bf(float f) { unsigned u = __builtin_bit_cast(unsigned, f); return (u + 0x7fffu + ((u >> 16) & 1u)) >> 16; }
__device__ __forceinline__ unsigned pk2(float lo, float hi) { return f2bf(lo) | (f2bf(hi) << 16); }
__device__ __forceinline__ float bflo(unsigned w) { return __uint_as_float(w << 16); }
__device__ __forceinline__ float bfhi(unsigned w) { return __uint_as_float(w & 0xffff0000u); }
__device__ __forceinline__ float sigm(float v) { return __builtin_amdgcn_rcpf(1.0f + __expf(-v)); }
__device__ __forceinline__ float wave_sum(float v) {
#pragma unroll
    for (int o = 1; o < 64; o <<= 1) v += __shfl_xor(v, o);
    return v;
}

struct Args { const float* in[13]; float* out; unsigned char* ws; int ph_lo, ph_hi; };
struct Ctx {
    LAS unsigned char* lds; int tid, lane, wave, vcu, G;
    const float *xp, *xs, *g_mix_pre, *w_in, *w_grp, *pool_scale, *rpb, *w_out, *g_mix_post, *g_ffn_pre, *w_gu, *w_down, *g_ffn_post;
    float* out; bf16 *W1t, *Wvt, *W2t, *W3t, *W4t, *XN, *Z, *VT, *MX, *T, *H2, *ACT, *FO; float* PS;
};
__device__ __forceinline__ const float* xrow(const Ctx& F, int m) { return m < MP ? F.xp + (size_t)m * D : F.xs + (size_t)(m - MP) * D; }

__device__ __forceinline__ void tr_item(const float* W, int ldw, int nsrc0, int k0, bf16* WT, int Kdst, int drow0, const float* gain, float mul, LAS float* scr, int lane) {
#pragma unroll 8
    for (int i = 0; i < 32; ++i) { const int kk = 2 * i + (lane >> 5); const float gsc = gain ? gain[k0 + kk] * mul : mul;
        scr[kk * 33 + (lane & 31)] = W[(size_t)(k0 + kk) * ldw + nsrc0 + (lane & 31)] * gsc; }
    LDS_WAIT(); asm volatile("" ::: "memory");
    const int c = lane & 7;
#pragma unroll
    for (int j = 0; j < 4; ++j) { const int n = (lane >> 3) + 8 * j; const LAS float* s = scr + (8 * c) * 33 + n;
        u32x4 o; o.x = pk2(s[0 * 33], s[1 * 33]); o.y = pk2(s[2 * 33], s[3 * 33]); o.z = pk2(s[4 * 33], s[5 * 33]); o.w = pk2(s[6 * 33], s[7 * 33]);
        *(u32x4*)(WT + (size_t)(drow0 + n) * Kdst + k0 + 8 * c) = o; }
    LDS_WAIT(); asm volatile("" ::: "memory");
}
__device__ __forceinline__ void tr_seg(const float* W, int ldw, int nsrc_base, int ncols, bf16* WT, int Kdst, int drow_base, const float* gain, float mul, LAS float* scr, int lane, int item) {
    const int nblk = ncols / 32, kb = item / nblk, nb = item % nblk;
    tr_item(W, ldw, nsrc_base + 32 * nb, 64 * kb, WT, Kdst, drow_base + 32 * nb, gain, mul, scr, lane);
}
__device__ __forceinline__ void fold_item(const Ctx& F, int item, int lane) {
    const int kb = item >> 7, nb = item & 127, grp = nb >> 5, d0 = (nb & 31) * 8, k = kb * 64 + lane;
    const float* a = F.w_in + (size_t)k * DIN + grp * 128; const float* bw = F.w_grp + (size_t)grp * 128 * 256 + d0;
    float acc[8];
#pragma unroll
    for (int e = 0; e < 8; ++e) acc[e] = 0.f;
    for (int c = 0; c < 128; c += 4) { const f32x4 av = *(const f32x4*)(a + c);
#pragma unroll
        for (int cc = 0; cc < 4; ++cc) { const f32x4 b0 = *(const f32x4*)(bw + (size_t)(c + cc) * 256), b1 = *(const f32x4*)(bw + (size_t)(c + cc) * 256 + 4);
            acc[0] += av[cc] * b0[0]; acc[1] += av[cc] * b0[1]; acc[2] += av[cc] * b0[2]; acc[3] += av[cc] * b0[3];
            acc[4] += av[cc] * b1[0]; acc[5] += av[cc] * b1[1]; acc[6] += av[cc] * b1[2]; acc[7] += av[cc] * b1[3]; } }
    const float gk = F.g_mix_pre[k];
#pragma unroll
    for (int e = 0; e < 8; ++e) { const int n = grp * 256 + d0 + e; F.W1t[(size_t)n * D + k] = (bf16)f2bf(acc[e] * gk * F.pool_scale[n]); }
}
__device__ __forceinline__ void rms_row_to_bf16(const float* xr_, bf16* orow, int lane) {
    const f32x4* xr = (const f32x4*)xr_ + lane;
    f32x4 v[4]; float s = 0.f;
#pragma unroll
    for (int j = 0; j < 4; ++j) { v[j] = xr[64 * j]; s += (v[j].x * v[j].x + v[j].y * v[j].y) + (v[j].z * v[j].z + v[j].w * v[j].w); }
    const float rstd = 1.0f / sqrtf(wave_sum(s) * (1.f / D) + EPS);
    unsigned long long* o8 = (unsigned long long*)orow + lane;
#pragma unroll
    for (int j = 0; j < 4; ++j) o8[64 * j] = (unsigned long long)pk2(v[j].x * rstd, v[j].y * rstd) | ((unsigned long long)pk2(v[j].z * rstd, v[j].w * rstd) << 32);
}
__device__ __forceinline__ void p0_prologue(const Ctx& F) {
    LAS float* scr = (LAS float*)(F.lds + F.wave * 16384);
    const int gw = F.vcu * NWAVES + F.wave, NGW = F.G * NWAVES, lane = F.lane;
    constexpr int I_Q = 16 * 16, I_K = 16 * 16, I_G = 16 * 64, I_V = 16 * 32, I_O = 16 * 32, I_GU = 16 * 176, I_DN = 44 * 32, I_FOLD = 16 * 128;
    constexpr int NITEMS = I_Q + I_K + I_G + I_V + I_O + I_GU + I_DN + I_FOLD;
    for (int it = gw; it < NITEMS; it += NGW) {
        int r = it;
        if (r < I_FOLD) { fold_item(F, r, lane); continue; } r -= I_FOLD;
        if (r < I_Q) { tr_seg(F.w_in, DIN, 512, 512, F.W1t, D, ZQ, F.g_mix_pre, 0.125f, scr, lane, r); continue; } r -= I_Q;
        if (r < I_K) { tr_seg(F.w_in, DIN, 1024, 512, F.W1t, D, ZK, F.g_mix_pre, 1.f, scr, lane, r); continue; } r -= I_K;
        if (r < I_G) { tr_seg(F.w_in, DIN, 2560, 2048, F.W1t, D, ZGP, F.g_mix_pre, 1.f, scr, lane, r); continue; } r -= I_G;
        if (r < I_V) { tr_seg(F.w_in, DIN, 1536, 1024, F.Wvt, D, 0, F.g_mix_pre, 1.f, scr, lane, r); continue; } r -= I_V;
        if (r < I_O) { tr_seg(F.w_out, D, 0, 1024, F.W2t, D, 0, nullptr, 1.f, scr, lane, r); continue; } r -= I_O;
        if (r < I_GU) {
            const int kb = r / 176, nb = r % 176, nsrc = 32 * nb, isup = nsrc >= DFF, nn = isup ? nsrc - DFF : nsrc;
            tr_item(F.w_gu, 2 * DFF, nsrc, 64 * kb, F.W3t, D, (nn >> 7) * 256 + (nn & 127) + (isup ? 128 : 0), F.g_ffn_pre, 1.f, scr, lane); continue; } r -= I_GU;
        tr_seg(F.w_down, D, 0, 1024, F.W4t, DFF, 0, nullptr, 1.f, scr, lane, r);
    }
    for (int m = gw; m < M; m += NGW) rms_row_to_bf16(xrow(F, m), F.XN + (size_t)m * D, lane);
}

template <int HW> __device__ __forceinline__ void pool_unit(const bf16* Zb, bf16* MXb, int r, int tid) {
    const bf16* zc = Zb + 2 * tid; constexpr int NU = 16 + 2 * HW - 1;
#pragma unroll 1
    for (int blk = 0; blk < 4; ++blk) {
        const int sb = r * GRID_W + 16 * blk;
        unsigned uu[NU], gp[16];
#pragma unroll
        for (int i = 0; i < NU; ++i) { const int j = sb - HW + i, jc = j < 0 ? 0 : (j > SEQ - 1 ? SEQ - 1 : j); const unsigned v = *(const unsigned*)(zc + (size_t)jc * NZ); uu[i] = (j == jc) ? v : 0u; }
#pragma unroll
        for (int c = 0; c < 16; ++c) gp[c] = *(const unsigned*)(zc + (size_t)(sb + c) * NZ + ZGP);
        float sum0 = 0.f, sum1 = 0.f;
#pragma unroll
        for (int i = 0; i < 2 * HW - 1; ++i) { sum0 += bflo(uu[i]); sum1 += bfhi(uu[i]); }
#pragma unroll
        for (int c = 0; c < 16; ++c) {
            sum0 += bflo(uu[c + 2 * HW - 1]); sum1 += bfhi(uu[c + 2 * HW - 1]);
            const int s = sb + c, lo = (s - HW) > 0 ? (s - HW) : 0, hi = (s + HW) < SEQ ? (s + HW) : SEQ; const float inv = 1.0f / (float)(hi - lo);
            const float o0 = (sum0 * inv - bflo(uu[c + HW])) * sigm(bflo(gp[c])), o1 = (sum1 * inv - bfhi(uu[c + HW])) * sigm(bfhi(gp[c]));
            *(unsigned*)(MXb + (size_t)s * D + 2 * tid) = pk2(o0, o1);
            sum0 -= bflo(uu[c]); sum1 -= bfhi(uu[c]);
        }
    }
}
__device__ __forceinline__ void pool_phase(const Ctx& F) {
    for (int unit = F.vcu; unit < NBATCH * GRID_H; unit += F.G) {
        const int b = unit >> 7, r = unit & 127; const bf16* Zb = F.Z + (size_t)b * SEQ * NZ; bf16* MXb = F.MX + (size_t)b * SEQ * D;
        switch (F.wave >> 1) { case 0: pool_unit<1>(Zb, MXb, r, F.tid); break; case 1: pool_unit<2>(Zb, MXb, r, F.tid); break; case 2: pool_unit<4>(Zb, MXb, r, F.tid); break; default: pool_unit<8>(Zb, MXb, r, F.tid); break; }
    }
}

constexpr int AT_ROWS = 80, AT_SLOTS = 9, AT_KR = 0, AT_VR = AT_SLOTS * 8192, AT_RPB = 2 * AT_SLOTS * 8192;
static_assert(AT_RPB + 465 * 4 <= LDS_BYTES && (NBATCH * GRID_H) % AT_ROWS == 0 && AT_ROWS % 2 == 0, "attention LDS map / chunking");
__device__ __forceinline__ int at_rs(int R) { const int r = R & 127, t = r - 4; return (R & ~127) + (t < 0 ? 0 : (t > GRID_H - 8 ? GRID_H - 8 : t)); }
__device__ __forceinline__ void attn_phase(const Ctx& F) {
    LAS unsigned char* KR = F.lds + AT_KR; LAS unsigned char* VR = F.lds + AT_VR; LAS float* rpbL = (LAS float*)(F.lds + AT_RPB);
    const int tid = F.tid, lane = F.lane, g = lane >> 4, li = lane & 15, wsel = F.wave >> 2, j = F.wave & 3;
    const int kc0 = (j == 0) ? 0 : (j == 1) ? 8 : (j == 2) ? 24 : 32, c = 16 * j + li, cs = (c - 8) < 0 ? 0 : ((c - 8) > GRID_W - 16 ? GRID_W - 16 : (c - 8));
    int dcv[8]; bool vld[8];
#pragma unroll
    for (int hf = 0; hf < 2; ++hf)
#pragma unroll
        for (int i = 0; i < 4; ++i) { const int kc = kc0 + 16 * hf + 4 * g + i; int dc = kc - c; vld[4 * hf + i] = (kc >= cs) && (kc < cs + 16); dcv[4 * hf + i] = dc < -15 ? -15 : (dc > 15 ? 15 : dc); }
    int koff[2][2], voff[4][2];
#pragma unroll
    for (int hf = 0; hf < 2; ++hf) { const int row = kc0 + 16 * hf + li, sw = (row >> 1) & 7; koff[hf][0] = row * 128 + ((g ^ sw) << 4); koff[hf][1] = row * 128 + (((4 + g) ^ sw) << 4); }
#pragma unroll
    for (int nb = 0; nb < 4; ++nb) { const int row = nb * 16 + li, sw = (row >> 1) & 7;
#pragma unroll
        for (int hf = 0; hf < 2; ++hf) { const int u = (kc0 >> 2) + g + 4 * hf; voff[nb][hf] = row * 128 + (((u >> 1) ^ sw) << 4) + ((u & 1) << 3); } }
    const int srow = tid >> 3, sch = tid & 7, sdst = srow * 128 + ((sch ^ ((srow >> 1) & 7)) << 4);
    for (int item = F.vcu; item < 256; item += F.G) {
        const int combo = item & 15, h = combo >> 1, e = combo & 1, Rbase = (item >> 4) * AT_ROWS;
        const bf16* ksrc = F.Z + (size_t)srow * NZ + ZK + h * 64 + sch * 8;
        const bf16* vsrc = F.VT + (size_t)(h * 128 + e * 64 + srow) * M + sch * 8;
        __syncthreads();
        for (int i = tid; i < 465; i += NTHR) rpbL[i] = F.rpb[h * 465 + i];
        int cur_hi = at_rs(Rbase);
        { const int nhi = at_rs(Rbase + 1) + 8;
          for (; cur_hi < nhi; ++cur_hi) { const int sl = cur_hi % AT_SLOTS;
              const u32x4 kv = *(const u32x4*)(ksrc + (size_t)cur_hi * 64 * NZ), vv = *(const u32x4*)(vsrc + (size_t)cur_hi * 64);
              *(LAS u32x4*)(KR + sl * 8192 + sdst) = kv; *(LAS u32x4*)(VR + sl * 8192 + sdst) = vv; } }
        bf16x8 Q0, Q1;
        { const bf16* qp = F.Z + ((size_t)(Rbase + wsel) * 64 + c) * NZ + ZQ + h * 64 + 8 * g; Q0 = *(const bf16x8*)qp; Q1 = *(const bf16x8*)(qp + 32); }
        __syncthreads();
#pragma unroll 1
        for (int step = 0; step < AT_ROWS / 2; ++step) {
            const int R0 = Rbase + 2 * step, R = R0 + wsel; const bool more = step + 1 < AT_ROWS / 2;
            int nhi = 0, pf_n = 0, pf_row = 0; u32x4 sk0, sv0, sk1, sv1; bf16x8 Qn0 = Q0, Qn1 = Q1;
            if (more) { const int nlo = at_rs(R0 + 2); nhi = at_rs(R0 + 3) + 8; if (cur_hi < nlo) cur_hi = nlo; pf_row = cur_hi; pf_n = nhi - cur_hi; pf_n = pf_n > 2 ? 2 : pf_n;
                if (pf_n > 0) { sk0 = *(const u32x4*)(ksrc + (size_t)pf_row * 64 * NZ); sv0 = *(const u32x4*)(vsrc + (size_t)pf_row * 64); }
                if (pf_n > 1) { sk1 = *(const u32x4*)(ksrc + (size_t)(pf_row + 1) * 64 * NZ); sv1 = *(const u32x4*)(vsrc + (size_t)(pf_row + 1) * 64); }
                const bf16* qp = F.Z + ((size_t)(R + 2) * 64 + c) * NZ + ZQ + h * 64 + 8 * g; Qn0 = *(const bf16x8*)qp; Qn1 = *(const bf16x8*)(qp + 32); }
            const int rsf = at_rs(R), slot0 = rsf % AT_SLOTS; const size_t tok = (size_t)R * 64 + c;
            const bf16* gap = F.Z + tok * NZ + ZGA + h * 128 + e * 64 + 4 * g; bf16* mp = F.MX + tok * D + h * 128 + e * 64 + 4 * g;
            u32x2 gav[4], mxv[4];
#pragma unroll
            for (int nb = 0; nb < 4; ++nb) { gav[nb] = *(const u32x2*)(gap + nb * 16); mxv[nb] = *(const u32x2*)(mp + nb * 16); }
            f32x4 sacc[8][2]; int sl = slot0;
#pragma unroll
            for (int kr = 0; kr < 8; ++kr) { const LAS unsigned char* kb = KR + sl * 8192;
#pragma unroll
                for (int hf = 0; hf < 2; ++hf) { const bf16x8 K0 = *(const LAS bf16x8*)(kb + koff[hf][0]), K1 = *(const LAS bf16x8*)(kb + koff[hf][1]);
                    f32x4 a = {0.f, 0.f, 0.f, 0.f};
                    a = __builtin_amdgcn_mfma_f32_16x16x32_bf16(K0, Q0, a, 0, 0, 0); a = __builtin_amdgcn_mfma_f32_16x16x32_bf16(K1, Q1, a, 0, 0, 0); sacc[kr][hf] = a; }
                sl = (sl + 1 == AT_SLOTS) ? 0 : sl + 1; }
            float mx = -INFINITY; const int drb = rsf - R + 7;
#pragma unroll
            for (int kr = 0; kr < 8; ++kr) { const LAS float* rp = rpbL + (drb + kr) * 31 + 15;
#pragma unroll
                for (int hf = 0; hf < 2; ++hf)
#pragma unroll
                    for (int i = 0; i < 4; ++i) { const float sv = vld[4 * hf + i] ? sacc[kr][hf][i] + rp[dcv[4 * hf + i]] : -INFINITY; sacc[kr][hf][i] = sv; mx = fmaxf(mx, sv); } }
            mx = fmaxf(mx, __shfl_xor(mx, 16)); mx = fmaxf(mx, __shfl_xor(mx, 32));
            float sum = 0.f; bf16x8 Pf[8];
#pragma unroll
            for (int kr = 0; kr < 8; ++kr) { float p[8];
#pragma unroll
                for (int hf = 0; hf < 2; ++hf)
#pragma unroll
                    for (int i = 0; i < 4; ++i) { const float pv = __expf(sacc[kr][hf][i] - mx); p[4 * hf + i] = pv; sum += pv; }
                u32x4 w; w.x = pg8::cvt_pk_bf16(p[0], p[1]); w.y = pg8::cvt_pk_bf16(p[2], p[3]); w.z = pg8::cvt_pk_bf16(p[4], p[5]); w.w = pg8::cvt_pk_bf16(p[6], p[7]);
                Pf[kr] = __builtin_bit_cast(bf16x8, w); }
            sum += __shfl_xor(sum, 16); sum += __shfl_xor(sum, 32);
            const float inv = 1.0f / sum;
            f32x4 oacc[4];
#pragma unroll
            for (int nb = 0; nb < 4; ++nb) oacc[nb] = (f32x4){0.f, 0.f, 0.f, 0.f};
            sl = slot0;
#pragma unroll
            for (int kr = 0; kr < 8; ++kr) { const LAS unsigned char* vb = VR + sl * 8192;
#pragma unroll
                for (int nb = 0; nb < 4; ++nb) { const u32x2 lo = *(const LAS u32x2*)(vb + voff[nb][0]), hi = *(const LAS u32x2*)(vb + voff[nb][1]); const u32x4 w = {lo.x, lo.y, hi.x, hi.y};
                    oacc[nb] = __builtin_amdgcn_mfma_f32_16x16x32_bf16(__builtin_bit_cast(bf16x8, w), Pf[kr], oacc[nb], 0, 0, 0); }
                sl = (sl + 1 == AT_SLOTS) ? 0 : sl + 1; }
#pragma unroll
            for (int nb = 0; nb < 4; ++nb) { const u32x2 ga = gav[nb], pa = mxv[nb];
                const float o0 = bflo(pa.x) + sigm(bflo(ga.x)) * oacc[nb][0] * inv, o1 = bfhi(pa.x) + sigm(bfhi(ga.x)) * oacc[nb][1] * inv;
                const float o2 = bflo(pa.y) + sigm(bflo(ga.y)) * oacc[nb][2] * inv, o3 = bfhi(pa.y) + sigm(bfhi(ga.y)) * oacc[nb][3] * inv;
                u32x2 w; w.x = pg8::cvt_pk_bf16(o0, o1); w.y = pg8::cvt_pk_bf16(o2, o3); *(u32x2*)(mp + nb * 16) = w; }
            __syncthreads();
            if (pf_n > 0) { const int s0 = pf_row % AT_SLOTS; *(LAS u32x4*)(KR + s0 * 8192 + sdst) = sk0; *(LAS u32x4*)(VR + s0 * 8192 + sdst) = sv0; }
            if (pf_n > 1) { const int s1 = (pf_row + 1) % AT_SLOTS; *(LAS u32x4*)(KR + s1 * 8192 + sdst) = sk1; *(LAS u32x4*)(VR + s1 * 8192 + sdst) = sv1; }
            cur_hi += pf_n;
            if (more) for (; cur_hi < nhi; ++cur_hi) { const int s2 = cur_hi % AT_SLOTS;
                const u32x4 kv = *(const u32x4*)(ksrc + (size_t)cur_hi * 64 * NZ), vv = *(const u32x4*)(vsrc + (size_t)cur_hi * 64);
                *(LAS u32x4*)(KR + s2 * 8192 + sdst) = kv; *(LAS u32x4*)(VR + s2 * 8192 + sdst) = vv; }
            Q0 = Qn0; Q1 = Qn1;
            __syncthreads();
        }
    }
}

template <bool SECOND> __device__ __forceinline__ void norm_rows(const Ctx& F) {
    const int gw = F.vcu * NWAVES + F.wave, NGW = F.G * NWAVES, lane = F.lane;
    const float* gpost = SECOND ? F.g_ffn_post : F.g_mix_post; const bf16* Tb = SECOND ? F.FO : F.T;
    f32x4 gv[4];
#pragma unroll
    for (int j = 0; j < 4; ++j) gv[j] = ((const f32x4*)gpost)[64 * j + lane];
    for (int m = gw; m < M; m += NGW) {
        float ss = F.PS[(size_t)m * 16 + (lane & 15)];
        ss += __shfl_xor(ss, 1); ss += __shfl_xor(ss, 2); ss += __shfl_xor(ss, 4); ss += __shfl_xor(ss, 8);
        const float rstdT = 1.0f / sqrtf(ss * (1.f / D) + EPS);
        const f32x4* xr = (const f32x4*)(SECOND ? F.out + (size_t)m * D : xrow(F, m)) + lane;
        const u32x2* tr = (const u32x2*)(Tb + (size_t)m * D) + lane;
        f32x4 v[4]; float s2 = 0.f;
#pragma unroll
        for (int j = 0; j < 4; ++j) { const f32x4 xv = xr[64 * j]; const u32x2 t = tr[64 * j];
            v[j].x = xv.x + bflo(t.x) * rstdT * gv[j].x; v[j].y = xv.y + bfhi(t.x) * rstdT * gv[j].y; v[j].z = xv.z + bflo(t.y) * rstdT * gv[j].z; v[j].w = xv.w + bfhi(t.y) * rstdT * gv[j].w;
            s2 += (v[j].x * v[j].x + v[j].y * v[j].y) + (v[j].z * v[j].z + v[j].w * v[j].w); }
        f32x4* orow = (f32x4*)(F.out + (size_t)m * D) + lane;
#pragma unroll
        for (int j = 0; j < 4; ++j) orow[64 * j] = v[j];
        if (!SECOND) {
            const float rstd = 1.0f / sqrtf(wave_sum(s2) * (1.f / D) + EPS);
            unsigned long long* o8 = (unsigned long long*)(F.H2 + (size_t)m * D) + lane;
#pragma unroll
            for (int j = 0; j < 4; ++j) o8[64 * j] = (unsigned long long)pk2(v[j].x * rstd, v[j].y * rstd) | ((unsigned long long)pk2(v[j].z * rstd, v[j].w * rstd) << 32);
        }
    }
}

#define REP_P0 1
#define REP_P2 1
#define REP_P4 1
#define REP_G 1
__global__ void __launch_bounds__(NTHR, 2) enc_fwd(Args args) {
    extern __shared__ __attribute__((aligned(16))) unsigned char lds[];
    cg::grid_group grid = cg::this_grid();
    Ctx F;
    F.lds = (LAS unsigned char*)lds;
    F.tid = threadIdx.x; F.lane = F.tid & 63; F.wave = __builtin_amdgcn_readfirstlane(F.tid >> 6);
    F.G = gridDim.x; { const int bx = blockIdx.x; F.vcu = (F.G % 8 == 0) ? (bx % 8) * (F.G / 8) + bx / 8 : bx; }
    unsigned char* ws = args.ws;
    F.xp = args.in[0]; F.xs = args.in[1]; F.g_mix_pre = args.in[2]; F.w_in = args.in[3]; F.w_grp = args.in[4]; F.pool_scale = args.in[5]; F.rpb = args.in[6]; F.w_out = args.in[7];
    F.g_mix_post = args.in[8]; F.g_ffn_pre = args.in[9]; F.w_gu = args.in[10]; F.w_down = args.in[11]; F.g_ffn_post = args.in[12]; F.out = args.out;
    F.W1t = (bf16*)(ws + WS_W1); F.Wvt = (bf16*)(ws + WS_WV); F.W2t = (bf16*)(ws + WS_W2); F.W3t = (bf16*)(ws + WS_W3); F.W4t = (bf16*)(ws + WS_W4); F.PS = (float*)(ws + WS_PS);
    F.XN = (bf16*)(ws + WS_XN); F.MX = F.XN; F.FO = F.XN; F.Z = (bf16*)(ws + WS_Z); F.ACT = F.Z; F.H2 = (bf16*)(ws + WS_H2); F.VT = (bf16*)(ws + WS_VT); F.T = F.VT;
    const int lo = args.ph_lo, hi = args.ph_hi;
#define IN(k) (lo <= (k) && (k) < hi)
#define SEAM(k) do { if (IN(k) && IN((k) + 1)) grid.sync(); } while (0)
#define REPEAT(n) for (int rep_ = 0; rep_ < (n); ++rep_, ((rep_ < (n)) ? grid.sync() : (void)0))
    if (IN(0)) { REPEAT(REP_P0) p0_prologue(F); } SEAM(0);
    if (IN(1)) { REPEAT(REP_G) {
        { pg8::Gemm g{F.XN, F.W1t, M, NZ, D}; pg8::StaticOrder S; S.init(M, NZ, F.G, (int)blockIdx.x); pg8::EpiPlain E{F.Z, NZ};
          pg8::gemm_phase<pg8::EpiPlain, pg8::StaticOrder, true, true>(F.lds, g, S, E); }
        { pg8::Gemm g{F.Wvt, F.XN, D, M, D}; pg8::StaticOrder S; S.init(D, M, F.G, (int)blockIdx.x); pg8::EpiPlain E{F.VT, M};
          pg8::gemm_phase<pg8::EpiPlain, pg8::StaticOrder, true, true>(F.lds, g, S, E); } }
    } SEAM(1);
    if (IN(2)) { REPEAT(REP_P2) pool_phase(F); } SEAM(2);
    if (IN(3)) { attn_phase(F); } SEAM(3);
    if (IN(4)) { REPEAT(REP_G) { pg8::Gemm g{F.MX, F.W2t, M, D, D}; pg8::StaticOrder S; S.init(M, D, F.G, (int)blockIdx.x); pg8::EpiSumsq E{F.T, D, F.PS};
        pg8::gemm_phase<pg8::EpiSumsq, pg8::StaticOrder, true, true>(F.lds, g, S, E); } } SEAM(4);
    if (IN(5)) { REPEAT(REP_P4) norm_rows<false>(F); } SEAM(5);
    if (IN(6)) { REPEAT(REP_G) { pg8::Gemm g{F.H2, F.W3t, M, 2 * DFF, D}; pg8::StaticOrder S; S.init(M, 2 * DFF, F.G, (int)blockIdx.x); pg8::EpiSwiglu E{F.ACT, DFF};
        pg8::gemm_phase<pg8::EpiSwiglu, pg8::StaticOrder, true, true>(F.lds, g, S, E); } } SEAM(6);
    if (IN(7)) { REPEAT(REP_G) { pg8::Gemm g{F.ACT, F.W4t, M, D, DFF}; pg8::StaticOrder S; S.init(M, D, F.G, (int)blockIdx.x); pg8::EpiSumsq E{F.FO, D, F.PS};
        pg8::gemm_phase<pg8::EpiSumsq, pg8::StaticOrder, true, true>(F.lds, g, S, E); } } SEAM(7);
    if (IN(8)) { norm_rows<true>(F); }
#undef REPEAT
#undef IN
#undef SEAM
}

#ifndef MK_PER_PHASE
#define MK_PER_PHASE 0
#endif
extern "C" void kernel_launch(void* const* d_in, const int* in_sizes, int n_in, void* d_out, int out_size, void* d_ws, size_t ws_size, hipStream_t stream) {
    static int grid = 0;
    if (grid == 0) {
        if (n_in != 13 || out_size != M * D || ws_size < WS_END) { fprintf(stderr, "kernel_launch: unexpected problem (n_in %d, out %d, ws %zu); nothing launched\n", n_in, out_size, ws_size); grid = -1; return; }
        int dev = 0, cus = 0, per_cu = 0;
        if (hipGetDevice(&dev) != hipSuccess || hipDeviceGetAttribute(&cus, hipDeviceAttributeMultiprocessorCount, dev) != hipSuccess) { grid = -1; return; }
        if (hipFuncSetAttribute((const void*)enc_fwd, hipFuncAttributeMaxDynamicSharedMemorySize, LDS_BYTES) != hipSuccess) { fprintf(stderr, "kernel_launch: hipFuncSetAttribute failed\n"); grid = -1; return; }
        if (hipOccupancyMaxActiveBlocksPerMultiprocessor(&per_cu, (const void*)enc_fwd, NTHR, LDS_BYTES) != hipSuccess || per_cu < 1) { fprintf(stderr, "kernel_launch: occupancy query says %d\n", per_cu); per_cu = 1; }
        (void)hipGetLastError();
        grid = cus;
    }
    if (grid < 0) return;
    Args a{};
    for (int i = 0; i < 13; ++i) a.in[i] = (const float*)d_in[i];
    a.out = (float*)d_out; a.ws = (unsigned char*)d_ws;
#if MK_PER_PHASE
    for (int p = 0; p < 9; ++p) { a.ph_lo = p; a.ph_hi = p + 1; hipLaunchKernelGGL(enc_fwd, dim3(grid), dim3(NTHR), LDS_BYTES, stream, a); }
#else
    a.ph_lo = 0; a.ph_hi = 9;
    void* kargs[] = {&a};
    const hipError_t e = hipLaunchCooperativeKernel((const void*)enc_fwd, dim3(grid), dim3(NTHR), kargs, LDS_BYTES, stream);
    if (e != hipSuccess) fprintf(stderr, "kernel_launch: cooperative launch failed: %s (grid %d)\n", hipGetErrorString(e), grid);
#endif
}
```

```cpp
#include <hip/hip_runtime.h>
#include <hip/hip_cooperative_groups.h>
#include <cstdio>
#include <cstdint>
namespace cg = cooperative_groups;
namespace pg8 {
#define PG8_LAS __attribute__((address_space(3)))
typedef unsigned short bf16_t;
typedef short bf16x8 __attribute__((ext_vector_type(8)));
typedef float f32x4 __attribute__((ext_vector_type(4)));
typedef unsigned u32x4 __attribute__((ext_vector_type(4)));
constexpr int BM = 256, BK = 64, HALF = 128, HTB = HALF * BK * 2  , STAGE_BYTES = 8 * HTB, NXCD = 8, WGM = 8;

__host__ __device__ __forceinline__ int lds_byte(int r, int c) { const int st = (r >> 4) * 2 + (c >> 5), rr = r & 15, cc = c & 31, ob = rr * 64 + cc * 2; return st * 1024 + (ob ^ (((ob >> 9) & 1) << 5)); }
__host__ __device__ __forceinline__ void stage_rc(int b, int& R, int& C) { const int st = b / 1024, sb = b % 1024, swz = sb ^ (((sb >> 9) & 1) << 5); R = (st >> 1) * 16 + swz / 64; C = (st & 1) * 32 + (swz % 64) / 2; }
__host__ __device__ __forceinline__ int perm32(int rho) { const int n = rho >> 4, i = rho & 15; return 8 * (i >> 2) + 4 * n + (i & 3); }

struct Unit { int pm, pn; };
struct Gemm { const bf16_t* A; const bf16_t* Bt; int M, N, K; };

struct StaticOrder {
    int nM, nN, nwg, G, c;
    __host__ __device__ void init(int M, int N, int G_, int c_) { nM = M / BM; nN = N / BM; nwg = nM * nN; G = G_; c = c_; }
    __host__ __device__ bool next(int i, Unit& u) const {
        const long L = (long)i * G + c; if (L >= nwg) return false;
        int wgid = (int)L; { const int q = nwg / NXCD, r = nwg % NXCD, xcd = wgid % NXCD, off = wgid / NXCD; wgid = (xcd < r ? xcd * (q + 1) : r * (q + 1) + (xcd - r) * q) + off; }
        const int nig = WGM * nN, gid = wgid / nig, fm = gid * WGM, gsz = (nM - fm) < WGM ? (nM - fm) : WGM;
        u.pm = fm + ((wgid % nig) % gsz); u.pn = (wgid % nig) / gsz; return true;
    }
    __device__ __forceinline__ void a_ready(const Unit&) const {}
    __device__ __forceinline__ void done(const Unit&) const {}
};

__device__ __forceinline__ unsigned cvt_pk_bf16(float lo, float hi) { unsigned r; asm volatile("v_cvt_pk_bf16_f32 %0, %1, %2" : "=v"(r) : "v"(lo), "v"(hi)); return r; }
typedef float f32x2 __attribute__((ext_vector_type(2)));
__device__ __forceinline__ float fast_sigmoid(float v) { return __builtin_amdgcn_rcpf(1.0f + __expf(-v)); }
struct EpiPlain {
    static constexpr bool PERM = true, AFTER_DRAIN = false;
    bf16_t* O; int ldc;
    __device__ __forceinline__ void operator()(const f32x4 (&acc)[2][2][4][2], const Unit& u, int wr, int wc, int fr, int fq) const {
        const int row0 = u.pm * BM + wr * 64 + fr, col0 = u.pn * BM + wc * 32 + 8 * fq;
#pragma unroll
        for (int ai = 0; ai < 2; ++ai)
#pragma unroll
            for (int m = 0; m < 4; ++m) { bf16_t* rowp = O + (size_t)(row0 + ai * HALF + m * 16) * ldc + col0;
#pragma unroll
                for (int bj = 0; bj < 2; ++bj) { const f32x4 v0 = acc[ai][bj][m][0], v1 = acc[ai][bj][m][1];
                    u32x4 w; w.x = cvt_pk_bf16(v0[0], v0[1]); w.y = cvt_pk_bf16(v0[2], v0[3]); w.z = cvt_pk_bf16(v1[0], v1[1]); w.w = cvt_pk_bf16(v1[2], v1[3]);
                    *(u32x4*)(rowp + bj * HALF) = w; } }
    }
};
struct EpiSumsq {
    static constexpr bool PERM = true, AFTER_DRAIN = false;
    bf16_t* O; int ldc; float* ps;
    __device__ __forceinline__ void operator()(const f32x4 (&acc)[2][2][4][2], const Unit& u, int wr, int wc, int fr, int fq) const {
        const int row0 = u.pm * BM + wr * 64 + fr, col0 = u.pn * BM + wc * 32 + 8 * fq;
#pragma unroll
        for (int ai = 0; ai < 2; ++ai)
#pragma unroll
            for (int m = 0; m < 4; ++m) { const int row = row0 + ai * HALF + m * 16; bf16_t* rowp = O + (size_t)row * ldc + col0; float s = 0.f;
#pragma unroll
                for (int bj = 0; bj < 2; ++bj) { const f32x4 v0 = acc[ai][bj][m][0], v1 = acc[ai][bj][m][1];
                    s += (v0[0] * v0[0] + v0[1] * v0[1]) + (v0[2] * v0[2] + v0[3] * v0[3]) + (v1[0] * v1[0] + v1[1] * v1[1]) + (v1[2] * v1[2] + v1[3] * v1[3]);
                    u32x4 w; w.x = cvt_pk_bf16(v0[0], v0[1]); w.y = cvt_pk_bf16(v0[2], v0[3]); w.z = cvt_pk_bf16(v1[0], v1[1]); w.w = cvt_pk_bf16(v1[2], v1[3]);
                    *(u32x4*)(rowp + bj * HALF) = w; }
                s += __shfl_xor(s, 16); s += __shfl_xor(s, 32);
                if (fq == 0) ps[(size_t)row * 16 + u.pn * 4 + wc] = s; }
    }
};
struct EpiSwiglu {
    static constexpr bool PERM = true, AFTER_DRAIN = false;
    bf16_t* O; int ldc;
    __device__ __forceinline__ void operator()(const f32x4 (&acc)[2][2][4][2], const Unit& u, int wr, int wc, int fr, int fq) const {
        const int row0 = u.pm * BM + wr * 64 + fr, col0 = u.pn * HALF + wc * 32 + 8 * fq;
#pragma unroll
        for (int ai = 0; ai < 2; ++ai)
#pragma unroll
            for (int m = 0; m < 4; ++m) { bf16_t* rowp = O + (size_t)(row0 + ai * HALF + m * 16) * ldc + col0;
                float a[8];
#pragma unroll
                for (int n = 0; n < 2; ++n)
#pragma unroll
                    for (int e = 0; e < 4; ++e) { const float gt = acc[ai][0][m][n][e], up = acc[ai][1][m][n][e]; a[4 * n + e] = gt * fast_sigmoid(gt) * up; }
                u32x4 w; w.x = cvt_pk_bf16(a[0], a[1]); w.y = cvt_pk_bf16(a[2], a[3]); w.z = cvt_pk_bf16(a[4], a[5]); w.w = cvt_pk_bf16(a[6], a[7]);
                *(u32x4*)rowp = w; }
    }
};
template <class Epi, class Sched, bool ALIGN_EPI = false, bool SP2 = false>
__device__ __forceinline__ void gemm_phase(PG8_LAS unsigned char* lds, const Gemm g, const Sched& S, const Epi& E) {
    const int tid = threadIdx.x, wid = __builtin_amdgcn_readfirstlane(tid >> 6), lane = tid & 63, wr = wid >> 2, wc = wid & 3, fr = lane & 15, fq = lane >> 4;
    const int K = g.K, nt = K / BK;
    unsigned voffA[2], voffB[2];
#pragma unroll
    for (int i = 0; i < 2; ++i) { int R, C; stage_rc(tid * 16 + i * 8192, R, C); const int Rb = Epi::PERM ? ((R & ~31) + perm32(R & 31)) : R;
        voffA[i] = (unsigned)(R * K + C) * 2u; voffB[i] = (unsigned)(Rb * K + C) * 2u; }
    const size_t kstep = (size_t)(BK * 2);
    const size_t hstep = (size_t)HALF * K * 2;
    const size_t tstep = 2 * hstep;
    const unsigned ldsw = (unsigned)wid * 1024u;
    const int aoff = lds_byte(wr * 64 + fr, fq * 8), boff = lds_byte(wc * 32 + fr, fq * 8);
#define PG8_SA(b, h) (((b) * 2 + (h)) * HTB)
#define PG8_SB(b, h) ((4 + (b) * 2 + (h)) * HTB)
#define PG8_STAGE(bufoff, gbase, voff) do { _Pragma("unroll") for (int _i = 0; _i < 2; ++_i) \
        __builtin_amdgcn_global_load_lds((const unsigned*)((const char*)(gbase) + (voff)[_i]), (PG8_LAS unsigned*)(lds + (bufoff) + ldsw + _i * 8192), 16, 0, 0); } while (0)
#define PG8_LDA(dst, b, h) do { _Pragma("unroll") for (int m = 0; m < 4; ++m) _Pragma("unroll") for (int k = 0; k < 2; ++k) dst[m][k] = *(const PG8_LAS bf16x8*)(lds + PG8_SA(b, h) + aoff + m * 2048 + k * 1024); } while (0)
#define PG8_LDB(dst, b, h) do { _Pragma("unroll") for (int n = 0; n < 2; ++n) _Pragma("unroll") for (int k = 0; k < 2; ++k) dst[n][k] = *(const PG8_LAS bf16x8*)(lds + PG8_SB(b, h) + boff + n * 2048 + k * 1024); } while (0)
#define PG8_MMA(ai, bj, At, Bt) do { __builtin_amdgcn_s_setprio(1); _Pragma("unroll") for (int m = 0; m < 4; ++m) _Pragma("unroll") for (int n = 0; n < 2; ++n) _Pragma("unroll") for (int k = 0; k < 2; ++k) \
        acc[ai][bj][m][n] = __builtin_amdgcn_mfma_f32_16x16x32_bf16(Bt[n][k], At[m][k], acc[ai][bj][m][n], 0, 0, 0); __builtin_amdgcn_s_setprio(0); } while (0)
#define PG8_WAIT_V(n) asm volatile("s_waitcnt vmcnt(" #n ")" ::: "memory")
#define PG8_WAIT_L(n) asm volatile("s_waitcnt lgkmcnt(" #n ")" ::: "memory")
#define PG8_BAR __builtin_amdgcn_s_barrier()
#define PG8_SCHED __builtin_amdgcn_sched_barrier(0)
    Unit cur, nxt; int ui = 0;
    if (!S.next(0, cur)) return;
    f32x4 acc[2][2][4][2];
#pragma unroll
    for (int a = 0; a < 2; ++a)
#pragma unroll
        for (int b = 0; b < 2; ++b)
#pragma unroll
            for (int m = 0; m < 4; ++m)
#pragma unroll
                for (int n = 0; n < 2; ++n) acc[a][b][m][n] = (f32x4){0.f, 0.f, 0.f, 0.f};
    bf16x8 At[4][2], B0[2][2], B1[2][2];
    const char* cA = (const char*)g.A + (size_t)cur.pm * tstep; const char* cB = (const char*)g.Bt + (size_t)cur.pn * tstep;
    S.a_ready(cur);
    if constexpr (SP2) {
        PG8_STAGE(PG8_SB(0, 0), cB, voffB); PG8_STAGE(PG8_SB(0, 1), cB + hstep, voffB); PG8_STAGE(PG8_SA(0, 0), cA, voffA); PG8_STAGE(PG8_SA(0, 1), cA + hstep, voffA);
        if (wr == 1) PG8_BAR;
        PG8_WAIT_V(2); PG8_BAR;
        PG8_STAGE(PG8_SB(1, 0), cB + kstep, voffB); PG8_STAGE(PG8_SA(1, 0), cA + kstep, voffA); PG8_STAGE(PG8_SB(1, 1), cB + hstep + kstep, voffB);
        PG8_WAIT_V(6); PG8_BAR;
    } else {
        PG8_STAGE(PG8_SB(0, 0), cB, voffB); PG8_STAGE(PG8_SA(0, 0), cA, voffA); PG8_STAGE(PG8_SB(0, 1), cB + hstep, voffB); PG8_STAGE(PG8_SA(0, 1), cA + hstep, voffA);
        if (wr == 1) PG8_BAR;
        PG8_WAIT_V(4); PG8_BAR;
        PG8_STAGE(PG8_SB(1, 0), cB + kstep, voffB); PG8_STAGE(PG8_SA(1, 0), cA + kstep, voffA); PG8_STAGE(PG8_SB(1, 1), cB + hstep + kstep, voffB);
        PG8_WAIT_V(6); PG8_BAR;
    }
    for (;;) {
        const bool has_next = S.next(ui + 1, nxt);
        const char* nA = has_next ? (const char*)g.A + (size_t)nxt.pm * tstep : cA; const char* nB = has_next ? (const char*)g.Bt + (size_t)nxt.pn * tstep : cB;
        for (int t = 0; t < nt; t += 2) {
            const bool last = (t == nt - 2);
            const char* a1 = cA + (size_t)(t + 1) * kstep;
            const char* a2 = last ? nA : cA + (size_t)(t + 2) * kstep; const char* b2 = last ? nB : cB + (size_t)(t + 2) * kstep;
            const char* a3 = a2 + kstep; const char* b3 = b2 + kstep;
            if (last && has_next) S.a_ready(nxt);
            if constexpr (SP2) {
            PG8_LDB(B0, 0, 0); PG8_LDB(B1, 0, 1); PG8_SCHED; PG8_LDA(At, 0, 0); PG8_STAGE(PG8_SA(1, 1), a1 + hstep, voffA);
            PG8_WAIT_V(8); PG8_WAIT_L(0); PG8_BAR; PG8_MMA(0, 0, At, B0); PG8_MMA(0, 1, At, B1); PG8_BAR; PG8_SCHED;
            PG8_LDA(At, 0, 1); PG8_STAGE(PG8_SB(0, 0), b2, voffB); PG8_STAGE(PG8_SB(0, 1), b2 + hstep, voffB); PG8_STAGE(PG8_SA(0, 0), a2, voffA);
            PG8_WAIT_V(8); PG8_WAIT_L(0); PG8_BAR; PG8_MMA(1, 0, At, B0); PG8_MMA(1, 1, At, B1); PG8_BAR; PG8_SCHED;
            PG8_LDB(B0, 1, 0); PG8_LDB(B1, 1, 1); PG8_SCHED; PG8_LDA(At, 1, 0); PG8_STAGE(PG8_SA(0, 1), a2 + hstep, voffA);
            PG8_WAIT_V(8); PG8_WAIT_L(0); PG8_BAR; PG8_MMA(0, 0, At, B0); PG8_MMA(0, 1, At, B1); PG8_BAR; PG8_SCHED;
            PG8_LDA(At, 1, 1); PG8_STAGE(PG8_SB(1, 0), b3, voffB); PG8_STAGE(PG8_SB(1, 1), b3 + hstep, voffB); PG8_STAGE(PG8_SA(1, 0), a3, voffA);
            PG8_WAIT_V(8); PG8_WAIT_L(0); PG8_BAR; PG8_MMA(1, 0, At, B0); PG8_MMA(1, 1, At, B1); PG8_BAR; PG8_SCHED;
            } else {
            PG8_LDB(B0, 0, 0); PG8_SCHED; PG8_LDA(At, 0, 0); PG8_STAGE(PG8_SA(1, 1), a1 + hstep, voffA);
            PG8_WAIT_L(8); PG8_BAR; PG8_WAIT_L(0); PG8_MMA(0, 0, At, B0); PG8_BAR; PG8_SCHED;
            PG8_LDB(B1, 0, 1); PG8_STAGE(PG8_SB(0, 0), b2, voffB);
            PG8_BAR; PG8_WAIT_L(0); PG8_MMA(0, 1, At, B1); PG8_BAR;
            PG8_LDA(At, 0, 1); PG8_STAGE(PG8_SA(0, 0), a2, voffA);
            PG8_BAR; PG8_WAIT_L(0); PG8_MMA(1, 0, At, B0); PG8_BAR; PG8_SCHED;
            PG8_STAGE(PG8_SB(0, 1), b2 + hstep, voffB);
            PG8_WAIT_V(6); PG8_BAR; PG8_MMA(1, 1, At, B1); PG8_BAR;
            PG8_LDB(B0, 1, 0); PG8_SCHED; PG8_LDA(At, 1, 0); PG8_STAGE(PG8_SA(0, 1), a2 + hstep, voffA);
            PG8_WAIT_L(8); PG8_BAR; PG8_WAIT_L(0); PG8_MMA(0, 0, At, B0); PG8_BAR; PG8_SCHED;
            PG8_LDB(B1, 1, 1); PG8_STAGE(PG8_SB(1, 0), b3, voffB);
            PG8_BAR; PG8_WAIT_L(0); PG8_MMA(0, 1, At, B1); PG8_BAR;
            PG8_LDA(At, 1, 1); PG8_STAGE(PG8_SA(1, 0), a3, voffA);
            PG8_BAR; PG8_WAIT_L(0); PG8_MMA(1, 0, At, B0); PG8_BAR; PG8_SCHED;
            PG8_STAGE(PG8_SB(1, 1), b3 + hstep, voffB);
            PG8_WAIT_V(6); PG8_BAR; PG8_MMA(1, 1, At, B1); PG8_BAR;
            }
        }
        if constexpr (ALIGN_EPI) { if (wr == 0) PG8_BAR; }
        if constexpr (!Epi::AFTER_DRAIN) { E(acc, cur, wr, wc, fr, fq); S.done(cur); }
        if (!has_next) break;
#pragma unroll
        for (int a = 0; a < 2; ++a)
#pragma unroll
            for (int b = 0; b < 2; ++b)
#pragma unroll
                for (int m = 0; m < 4; ++m)
#pragma unroll
                    for (int n = 0; n < 2; ++n) acc[a][b][m][n] = (f32x4){0.f, 0.f, 0.f, 0.f};
        cur = nxt; cA = nA; cB = nB; ++ui;
        if constexpr (ALIGN_EPI) { if (wr == 1) PG8_BAR; }
    }
    PG8_WAIT_V(0);
    if constexpr (!ALIGN_EPI) { if (wr == 0) PG8_BAR; }
    PG8_BAR;
    if constexpr (Epi::AFTER_DRAIN) { E.fused(acc, cur, wr, wc, fr, fq, lds, wid, lane); S.done(cur); }
#undef PG8_SA
#undef PG8_SB
#undef PG8_STAGE
#undef PG8_LDA
#undef PG8_LDB
#undef PG8_MMA
#undef PG8_WAIT_V
#undef PG8_WAIT_L
#undef PG8_BAR
#undef PG8_SCHED
}
}
constexpr int NWAVES = 8, NTHR = NWAVES * 64;
constexpr int D = 1024, SEQ = 8192, NBATCH = 10, M = NBATCH * SEQ, MP = 2 * SEQ;
constexpr int DIN = 4608, DFF = 2816, NZ = 4096;
constexpr int ZQ = 1024, ZK = 1536, ZGP = 2048, ZGA = 3072;
constexpr int GRID_W = 64, GRID_H = SEQ / GRID_W;
constexpr float EPS = 1e-6f;
constexpr size_t MiB = 1u << 20;
constexpr size_t WS_W1 = 1 * MiB, WS_WV = 9 * MiB, WS_W2 = 11 * MiB, WS_W3 = 13 * MiB, WS_W4 = 24 * MiB, WS_PS = 30 * MiB;
constexpr size_t WS_XN = 36 * MiB;
constexpr size_t WS_Z = 196 * MiB;
constexpr size_t WS_H2 = WS_Z + 440 * MiB;
constexpr size_t WS_VT = 836 * MiB;
constexpr size_t WS_END = 996 * MiB;
static_assert(WS_W4 + (size_t)D * DFF * 2 <= WS_PS && WS_PS + (size_t)M * 16 * 4 <= WS_XN && WS_XN + (size_t)M * D * 2 <= WS_Z && WS_Z + (size_t)M * NZ * 2 <= WS_VT &&
              (size_t)M * DFF * 2 <= 440 * MiB && WS_H2 + (size_t)M * D * 2 <= WS_VT && WS_VT + (size_t)M * D * 2 <= WS_END, "d_ws map");
constexpr int PA_STRIDE = 2080;
constexpr int PA_BYTES = 64 * PA_STRIDE;
constexpr int RPB_N = 8 * 15 * 31;
constexpr int LDS_BYTES = 155648;
static_assert(PA_BYTES + RPB_N * 4 <= LDS_BYTES && pg8::STAGE_BYTES <= LDS_BYTES, "LDS map");

#define LAS __attribute__((address_space(3)))
typedef unsigned short bf16;
typedef float f32x4 __attribute__((ext_vector_type(4)));
typedef short bf16x8 __attribute__((ext_vector_type(8)));
typedef unsigned u32x2 __attribute__((ext_vector_type(2)));
typedef unsigned u32x4 __attribute__((ext_vector_type(4)));
#define LDS_WAIT() asm volatile("s_waitcnt lgkmcnt(0)" ::: "memory")
__device__ __forceinline__ unsigned f2bf(float f) { unsigned u = __builtin_bit_cast(unsigned, f); return (u + 0x7fffu + ((u >> 16) & 1u)) >> 16; }
__device__ __forceinline__ unsigned pk2(float lo, float hi) { return f2bf(lo) | (f2bf(hi) << 16); }
__device__ __forceinline__ float bflo(unsigned w) { return __uint_as_float(w << 16); }
__device__ __forceinline__ float bfhi(unsigned w) { return __uint_as_float(w & 0xffff0000u); }
__device__ __forceinline__ float sigm(float v) { return __builtin_amdgcn_rcpf(1.0f + __expf(-v)); }
__device__ __forceinline__ float wave_sum(float v) {
#pragma unroll
    for (int o = 1; o < 64; o <<= 1) v += __shfl_xor(v, o);
    return v;
}

struct Args { const float* in[13]; float* out; unsigned char* ws; int ph_lo, ph_hi; };
struct Ctx {
    LAS unsigned char* lds; int tid, lane, wave, vcu, G;
    const float *xp, *xs, *g_mix_pre, *w_in, *w_grp, *pool_scale, *rpb, *w_out, *g_mix_post, *g_ffn_pre, *w_gu, *w_down, *g_ffn_post;
    float* out; bf16 *W1t, *Wvt, *W2t, *W3t, *W4t, *XN, *Z, *VT, *MX, *T, *H2, *ACT, *FO; float* PS;
};
__device__ __forceinline__ const float* xrow(const Ctx& F, int m) { return m < MP ? F.xp + (size_t)m * D : F.xs + (size_t)(m - MP) * D; }

__device__ __forceinline__ void tr_item(const float* W, int ldw, int nsrc0, int k0, bf16* WT, int Kdst, int drow0, const float* gain, float mul, LAS float* scr, int lane) {
#pragma unroll 8
    for (int i = 0; i < 32; ++i) { const int kk = 2 * i + (lane >> 5); const float gsc = gain ? gain[k0 + kk] * mul : mul;
        scr[kk * 33 + (lane & 31)] = W[(size_t)(k0 + kk) * ldw + nsrc0 + (lane & 31)] * gsc; }
    LDS_WAIT(); asm volatile("" ::: "memory");
    const int c = lane & 7;
#pragma unroll
    for (int j = 0; j < 4; ++j) { const int n = (lane >> 3) + 8 * j; const LAS float* s = scr + (8 * c) * 33 + n;
        u32x4 o; o.x = pk2(s[0 * 33], s[1 * 33]); o.y = pk2(s[2 * 33], s[3 * 33]); o.z = pk2(s[4 * 33], s[5 * 33]); o.w = pk2(s[6 * 33], s[7 * 33]);
        *(u32x4*)(WT + (size_t)(drow0 + n) * Kdst + k0 + 8 * c) = o; }
    LDS_WAIT(); asm volatile("" ::: "memory");
}
__device__ __forceinline__ void tr_seg(const float* W, int ldw, int nsrc_base, int ncols, bf16* WT, int Kdst, int drow_base, const float* gain, float mul, LAS float* scr, int lane, int item) {
    const int nblk = ncols / 32, kb = item / nblk, nb = item % nblk;
    tr_item(W, ldw, nsrc_base + 32 * nb, 64 * kb, WT, Kdst, drow_base + 32 * nb, gain, mul, scr, lane);
}
__device__ __forceinline__ void fold_item(const Ctx& F, int item, int lane) {
    const int kb = item >> 7, nb = item & 127, grp = nb >> 5, d0 = (nb & 31) * 8, k = kb * 64 + lane;
    const float* a = F.w_in + (size_t)k * DIN + grp * 128; const float* bw = F.w_grp + (size_t)grp * 128 * 256 + d0;
    float acc[8];
#pragma unroll
    for (int e = 0; e < 8; ++e) acc[e] = 0.f;
    for (int c = 0; c < 128; c += 4) { const f32x4 av = *(const f32x4*)(a + c);
#pragma unroll
        for (int cc = 0; cc < 4; ++cc) { const f32x4 b0 = *(const f32x4*)(bw + (size_t)(c + cc) * 256), b1 = *(const f32x4*)(bw + (size_t)(c + cc) * 256 + 4);
            acc[0] += av[cc] * b0[0]; acc[1] += av[cc] * b0[1]; acc[2] += av[cc] * b0[2]; acc[3] += av[cc] * b0[3];
            acc[4] += av[cc] * b1[0]; acc[5] += av[cc] * b1[1]; acc[6] += av[cc] * b1[2]; acc[7] += av[cc] * b1[3]; } }
    const float gk = F.g_mix_pre[k];
#pragma unroll
    for (int e = 0; e < 8; ++e) { const int n = grp * 256 + d0 + e; F.W1t[(size_t)n * D + k] = (bf16)f2bf(acc[e] * gk * F.pool_scale[n]); }
}
__device__ __forceinline__ void rms_row_to_bf16(const float* xr_, bf16* orow, int lane) {
    const f32x4* xr = (const f32x4*)xr_ + lane;
    f32x4 v[4]; float s = 0.f;
#pragma unroll
    for (int j = 0; j < 4; ++j) { v[j] = xr[64 * j]; s += (v[j].x * v[j].x + v[j].y * v[j].y) + (v[j].z * v[j].z + v[j].w * v[j].w); }
    const float rstd = 1.0f / sqrtf(wave_sum(s) * (1.f / D) + EPS);
    unsigned long long* o8 = (unsigned long long*)orow + lane;
#pragma unroll
    for (int j = 0; j < 4; ++j) o8[64 * j] = (unsigned long long)pk2(v[j].x * rstd, v[j].y * rstd) | ((unsigned long long)pk2(v[j].z * rstd, v[j].w * rstd) << 32);
}
__device__ __forceinline__ void p0_prologue(const Ctx& F) {
    LAS float* scr = (LAS float*)(F.lds + F.wave * 16384);
    const int gw = F.vcu * NWAVES + F.wave, NGW = F.G * NWAVES, lane = F.lane;
    constexpr int I_Q = 16 * 16, I_K = 16 * 16, I_G = 16 * 64, I_V = 16 * 32, I_O = 16 * 32, I_GU = 16 * 176, I_DN = 44 * 32, I_FOLD = 16 * 128;
    constexpr int NITEMS = I_Q + I_K + I_G + I_V + I_O + I_GU + I_DN + I_FOLD;
    for (int it = gw; it < NITEMS; it += NGW) {
        int r = it;
        if (r < I_FOLD) { fold_item(F, r, lane); continue; } r -= I_FOLD;
        if (r < I_Q) { tr_seg(F.w_in, DIN, 512, 512, F.W1t, D, ZQ, F.g_mix_pre, 0.125f * 1.4426950408889634f, scr, lane, r); continue; } r -= I_Q;
        if (r < I_K) { tr_seg(F.w_in, DIN, 1024, 512, F.W1t, D, ZK, F.g_mix_pre, 1.f, scr, lane, r); continue; } r -= I_K;
        if (r < I_G) { tr_seg(F.w_in, DIN, 2560, 2048, F.W1t, D, ZGP, F.g_mix_pre, 1.f, scr, lane, r); continue; } r -= I_G;
        if (r < I_V) { tr_seg(F.w_in, DIN, 1536, 1024, F.Wvt, D, 0, F.g_mix_pre, 1.f, scr, lane, r); continue; } r -= I_V;
        if (r < I_O) { tr_seg(F.w_out, D, 0, 1024, F.W2t, D, 0, nullptr, 1.f, scr, lane, r); continue; } r -= I_O;
        if (r < I_GU) {
            const int kb = r / 176, nb = r % 176, nsrc = 32 * nb, isup = nsrc >= DFF, nn = isup ? nsrc - DFF : nsrc;
            tr_item(F.w_gu, 2 * DFF, nsrc, 64 * kb, F.W3t, D, (nn >> 7) * 256 + (nn & 127) + (isup ? 128 : 0), F.g_ffn_pre, 1.f, scr, lane); continue; } r -= I_GU;
        tr_seg(F.w_down, D, 0, 1024, F.W4t, DFF, 0, nullptr, 1.f, scr, lane, r);
    }
    f32x4 cv[4], nv[4];
    if (gw < M) { const f32x4* xr = (const f32x4*)xrow(F, gw) + lane;
#pragma unroll
        for (int j = 0; j < 4; ++j) cv[j] = xr[64 * j]; }
#pragma unroll 1
    for (int m = gw; m < M; m += NGW) {
#pragma unroll
        for (int j = 0; j < 4; ++j) nv[j] = cv[j];
        if (m + NGW < M) { const f32x4* xr = (const f32x4*)xrow(F, m + NGW) + lane;
#pragma unroll
            for (int j = 0; j < 4; ++j) nv[j] = xr[64 * j]; }
        float sq = 0.f;
#pragma unroll
        for (int j = 0; j < 4; ++j) sq += (cv[j].x * cv[j].x + cv[j].y * cv[j].y) + (cv[j].z * cv[j].z + cv[j].w * cv[j].w);
        const float rstd = 1.0f / sqrtf(wave_sum(sq) * (1.f / D) + EPS);
        unsigned long long* o8 = (unsigned long long*)(F.XN + (size_t)m * D) + lane;
#pragma unroll
        for (int j = 0; j < 4; ++j) { o8[64 * j] = (unsigned long long)pk2(cv[j].x * rstd, cv[j].y * rstd) | ((unsigned long long)pk2(cv[j].z * rstd, cv[j].w * rstd) << 32); cv[j] = nv[j]; }
    }
}

template <int HW> struct PoolBuf { unsigned uu[16 + 2 * HW - 1], gp[16]; };
template <int HW> __device__ __forceinline__ void pool_load(const Ctx& F, int q, PoolBuf<HW>& B) {
    const int unit = F.vcu + (q >> 2) * F.G, b = unit >> 7, sb = (unit & 127) * GRID_W + 16 * (q & 3); const bf16* zc = F.Z + (size_t)b * SEQ * NZ + 2 * F.tid;
#pragma unroll
    for (int i = 0; i < 16 + 2 * HW - 1; ++i) { const int j = sb - HW + i, jc = j < 0 ? 0 : (j > SEQ - 1 ? SEQ - 1 : j); const unsigned v = *(const unsigned*)(zc + (size_t)jc * NZ); B.uu[i] = (j == jc) ? v : 0u; }
#pragma unroll
    for (int c = 0; c < 16; ++c) B.gp[c] = *(const unsigned*)(zc + (size_t)(sb + c) * NZ + ZGP);
}
template <int HW> __device__ __forceinline__ void pool_compute(const Ctx& F, int q, const PoolBuf<HW>& B) {
    const int unit = F.vcu + (q >> 2) * F.G, b = unit >> 7, sb = (unit & 127) * GRID_W + 16 * (q & 3); bf16* mo = F.MX + (size_t)b * SEQ * D + 2 * F.tid;
    float sum0 = 0.f, sum1 = 0.f;
#pragma unroll
    for (int i = 0; i < 2 * HW - 1; ++i) { sum0 += bflo(B.uu[i]); sum1 += bfhi(B.uu[i]); }
#pragma unroll
    for (int c = 0; c < 16; ++c) {
        sum0 += bflo(B.uu[c + 2 * HW - 1]); sum1 += bfhi(B.uu[c + 2 * HW - 1]);
        const int s = sb + c, lo = (s - HW) > 0 ? (s - HW) : 0, hi = (s + HW) < SEQ ? (s + HW) : SEQ; const float inv = 1.0f / (float)(hi - lo);
        const float o0 = (sum0 * inv - bflo(B.uu[c + HW])) * sigm(bflo(B.gp[c])), o1 = (sum1 * inv - bfhi(B.uu[c + HW])) * sigm(bfhi(B.gp[c]));
        *(unsigned*)(mo + (size_t)s * D) = pk2(o0, o1);
        sum0 -= bflo(B.uu[c]); sum1 -= bfhi(B.uu[c]);
    }
}
template <int HW> __device__ __forceinline__ void pool_stream(const Ctx& F) {
    const int nun = NBATCH * GRID_H, nq = F.vcu < nun ? 4 * ((nun - F.vcu + F.G - 1) / F.G) : 0;
    if (nq == 0) return;
    PoolBuf<HW> A, B;
    pool_load<HW>(F, 0, A);
#pragma unroll 1
    for (int q = 0; q < nq; q += 2) {
        if (q + 1 < nq) pool_load<HW>(F, q + 1, B);
        pool_compute<HW>(F, q, A);
        if (q + 2 < nq) pool_load<HW>(F, q + 2, A);
        if (q + 1 < nq) pool_compute<HW>(F, q + 1, B);
    }
}
__device__ __forceinline__ void pool_phase(const Ctx& F) {
    switch (F.wave >> 1) { case 0: pool_stream<1>(F); break; case 1: pool_stream<2>(F); break; case 2: pool_stream<4>(F); break; default: pool_stream<8>(F); break; }
}

constexpr int AT_ROWS = 80, AT_SLOTS = 9, AT_KR = 0, AT_VR = AT_SLOTS * 8192, AT_RPB = 2 * AT_SLOTS * 8192;
static_assert(AT_RPB + 15 * 32 * 4 <= LDS_BYTES && (NBATCH * GRID_H) % AT_ROWS == 0 && AT_ROWS % 2 == 0, "attention LDS map / chunking");
__device__ __forceinline__ int at_rs(int R) { const int r = R & 127, t = r - 4; return (R & ~127) + (t < 0 ? 0 : (t > GRID_H - 8 ? GRID_H - 8 : t)); }
__device__ __forceinline__ void attn_phase(const Ctx& F) {
    LAS unsigned char* KR = F.lds + AT_KR; LAS unsigned char* VR = F.lds + AT_VR; LAS float* rpbL = (LAS float*)(F.lds + AT_RPB);
    const int tid = F.tid, lane = F.lane, g = lane >> 4, li = lane & 15, wsel = F.wave >> 2, j = F.wave & 3;
    const int kc0 = (j == 0) ? 0 : (j == 1) ? 8 : (j == 2) ? 24 : 32, c = 16 * j + li, cs = (c - 8) < 0 ? 0 : ((c - 8) > GRID_W - 16 ? GRID_W - 16 : (c - 8));
    int boff[8];
#pragma unroll
    for (int hf = 0; hf < 2; ++hf)
#pragma unroll
        for (int i = 0; i < 4; ++i) { const int kc = kc0 + 16 * hf + 4 * g + i; boff[4 * hf + i] = ((kc >= cs) && (kc < cs + 16)) ? (kc - c + 15) : 31; }
    int koff[2][2], voff[4][2];
#pragma unroll
    for (int hf = 0; hf < 2; ++hf) { const int row = kc0 + 16 * hf + li, sw = (row >> 1) & 7; koff[hf][0] = row * 128 + ((g ^ sw) << 4); koff[hf][1] = row * 128 + (((4 + g) ^ sw) << 4); }
#pragma unroll
    for (int nb = 0; nb < 4; ++nb) { const int row = nb * 16 + li, sw = (row >> 1) & 7;
#pragma unroll
        for (int hf = 0; hf < 2; ++hf) { const int u = (kc0 >> 2) + g + 4 * hf; voff[nb][hf] = row * 128 + (((u >> 1) ^ sw) << 4) + ((u & 1) << 3); } }
    const int srow = tid >> 3, sch = tid & 7, sdst = srow * 128 + ((sch ^ ((srow >> 1) & 7)) << 4);
    for (int item = F.vcu; item < 256; item += F.G) {
        const int combo = item & 15, h = combo >> 1, e = combo & 1, Rbase = (item >> 4) * AT_ROWS;
        const bf16* ksrc = F.Z + (size_t)srow * NZ + ZK + h * 64 + sch * 8;
        const bf16* vsrc = F.VT + (size_t)(h * 128 + e * 64 + srow) * M + sch * 8;
        __syncthreads();
        for (int i = tid; i < 15 * 32; i += NTHR) rpbL[i] = ((i & 31) < 31) ? F.rpb[h * 465 + (i >> 5) * 31 + (i & 31)] * 1.4426950408889634f : -INFINITY;
        int cur_hi = at_rs(Rbase);
        { const int nhi = at_rs(Rbase + 1) + 8;
          for (; cur_hi < nhi; ++cur_hi) { const int sl = cur_hi % AT_SLOTS;
              const u32x4 kv = *(const u32x4*)(ksrc + (size_t)cur_hi * 64 * NZ), vv = *(const u32x4*)(vsrc + (size_t)cur_hi * 64);
              *(LAS u32x4*)(KR + sl * 8192 + sdst) = kv; *(LAS u32x4*)(VR + sl * 8192 + sdst) = vv; } }
        bf16x8 Q0, Q1;
        { const bf16* qp = F.Z + ((size_t)(Rbase + wsel) * 64 + c) * NZ + ZQ + h * 64 + 8 * g; Q0 = *(const bf16x8*)qp; Q1 = *(const bf16x8*)(qp + 32); }
        __syncthreads();
#pragma unroll 1
        for (int step = 0; step < AT_ROWS / 2; ++step) {
            const int R0 = Rbase + 2 * step, R = R0 + wsel; const bool more = step + 1 < AT_ROWS / 2;
            int nhi = 0, pf_n = 0, pf_row = 0; u32x4 sk0, sv0, sk1, sv1; bf16x8 Qn0 = Q0, Qn1 = Q1;
            if (more) { const int nlo = at_rs(R0 + 2); nhi = at_rs(R0 + 3) + 8; if (cur_hi < nlo) cur_hi = nlo; pf_row = cur_hi; pf_n = nhi - cur_hi; pf_n = pf_n > 2 ? 2 : pf_n;
                if (pf_n > 0) { sk0 = *(const u32x4*)(ksrc + (size_t)pf_row * 64 * NZ); sv0 = *(const u32x4*)(vsrc + (size_t)pf_row * 64); }
                if (pf_n > 1) { sk1 = *(const u32x4*)(ksrc + (size_t)(pf_row + 1) * 64 * NZ); sv1 = *(const u32x4*)(vsrc + (size_t)(pf_row + 1) * 64); }
                const bf16* qp = F.Z + ((size_t)(R + 2) * 64 + c) * NZ + ZQ + h * 64 + 8 * g; Qn0 = *(const bf16x8*)qp; Qn1 = *(const bf16x8*)(qp + 32); }
            const int rsf = at_rs(R), slot0 = rsf % AT_SLOTS; const size_t tok = (size_t)R * 64 + c;
            const bf16* gap = F.Z + tok * NZ + ZGA + h * 128 + e * 64 + 4 * g; bf16* mp = F.MX + tok * D + h * 128 + e * 64 + 4 * g;
            u32x2 gav[4], mxv[4];
#pragma unroll
            for (int nb = 0; nb < 4; ++nb) { gav[nb] = *(const u32x2*)(gap + nb * 16); mxv[nb] = *(const u32x2*)(mp + nb * 16); }
            f32x4 sacc[8][2]; int sl = slot0; const LAS float* rp0 = rpbL + (rsf - R + 7) * 32;
#pragma unroll
            for (int kr = 0; kr < 8; ++kr) { const LAS unsigned char* kb = KR + sl * 8192; const LAS float* rp = rp0 + kr * 32;
#pragma unroll
                for (int hf = 0; hf < 2; ++hf) { const bf16x8 K0 = *(const LAS bf16x8*)(kb + koff[hf][0]), K1 = *(const LAS bf16x8*)(kb + koff[hf][1]);
                    f32x4 a; a[0] = rp[boff[4 * hf + 0]]; a[1] = rp[boff[4 * hf + 1]]; a[2] = rp[boff[4 * hf + 2]]; a[3] = rp[boff[4 * hf + 3]];
                    a = __builtin_amdgcn_mfma_f32_16x16x32_bf16(K0, Q0, a, 0, 0, 0); a = __builtin_amdgcn_mfma_f32_16x16x32_bf16(K1, Q1, a, 0, 0, 0); sacc[kr][hf] = a; }
                sl = (sl + 1 == AT_SLOTS) ? 0 : sl + 1; }
            float mx = -INFINITY;
#pragma unroll
            for (int kr = 0; kr < 8; ++kr)
#pragma unroll
                for (int hf = 0; hf < 2; ++hf) mx = fmaxf(fmaxf(mx, fmaxf(sacc[kr][hf][0], sacc[kr][hf][1])), fmaxf(sacc[kr][hf][2], sacc[kr][hf][3]));
            mx = fmaxf(mx, __shfl_xor(mx, 16)); mx = fmaxf(mx, __shfl_xor(mx, 32));
            float sum = 0.f; bf16x8 Pf[8];
#pragma unroll
            for (int kr = 0; kr < 8; ++kr) { float p[8];
#pragma unroll
                for (int hf = 0; hf < 2; ++hf)
#pragma unroll
                    for (int i = 0; i < 4; ++i) { const float pv = __builtin_amdgcn_exp2f(sacc[kr][hf][i] - mx); p[4 * hf + i] = pv; sum += pv; }
                u32x4 w; w.x = pg8::cvt_pk_bf16(p[0], p[1]); w.y = pg8::cvt_pk_bf16(p[2], p[3]); w.z = pg8::cvt_pk_bf16(p[4], p[5]); w.w = pg8::cvt_pk_bf16(p[6], p[7]);
                Pf[kr] = __builtin_bit_cast(bf16x8, w); }
            sum += __shfl_xor(sum, 16); sum += __shfl_xor(sum, 32);
            const float inv = 1.0f / sum;
            f32x4 oacc[4];
#pragma unroll
            for (int nb = 0; nb < 4; ++nb) oacc[nb] = (f32x4){0.f, 0.f, 0.f, 0.f};
            sl = slot0;
#pragma unroll
            for (int kr = 0; kr < 8; ++kr) { const LAS unsigned char* vb = VR + sl * 8192;
#pragma unroll
                for (int nb = 0; nb < 4; ++nb) { const u32x2 lo = *(const LAS u32x2*)(vb + voff[nb][0]), hi = *(const LAS u32x2*)(vb + voff[nb][1]); const u32x4 w = {lo.x, lo.y, hi.x, hi.y};
                    oacc[nb] = __builtin_amdgcn_mfma_f32_16x16x32_bf16(__builtin_bit_cast(bf16x8, w), Pf[kr], oacc[nb], 0, 0, 0); }
                sl = (sl + 1 == AT_SLOTS) ? 0 : sl + 1; }
#pragma unroll
            for (int nb = 0; nb < 4; ++nb) { const u32x2 ga = gav[nb], pa = mxv[nb];
                const float o0 = bflo(pa.x) + sigm(bflo(ga.x)) * oacc[nb][0] * inv, o1 = bfhi(pa.x) + sigm(bfhi(ga.x)) * oacc[nb][1] * inv;
                const float o2 = bflo(pa.y) + sigm(bflo(ga.y)) * oacc[nb][2] * inv, o3 = bfhi(pa.y) + sigm(bfhi(ga.y)) * oacc[nb][3] * inv;
                u32x2 w; w.x = pg8::cvt_pk_bf16(o0, o1); w.y = pg8::cvt_pk_bf16(o2, o3); *(u32x2*)(mp + nb * 16) = w; }
            __syncthreads();
            if (pf_n > 0) { const int s0 = pf_row % AT_SLOTS; *(LAS u32x4*)(KR + s0 * 8192 + sdst) = sk0; *(LAS u32x4*)(VR + s0 * 8192 + sdst) = sv0; }
            if (pf_n > 1) { const int s1 = (pf_row + 1) % AT_SLOTS; *(LAS u32x4*)(KR + s1 * 8192 + sdst) = sk1; *(LAS u32x4*)(VR + s1 * 8192 + sdst) = sv1; }
            cur_hi += pf_n;
            if (more) for (; cur_hi < nhi; ++cur_hi) { const int s2 = cur_hi % AT_SLOTS;
                const u32x4 kv = *(const u32x4*)(ksrc + (size_t)cur_hi * 64 * NZ), vv = *(const u32x4*)(vsrc + (size_t)cur_hi * 64);
                *(LAS u32x4*)(KR + s2 * 8192 + sdst) = kv; *(LAS u32x4*)(VR + s2 * 8192 + sdst) = vv; }
            Q0 = Qn0; Q1 = Qn1;
            __syncthreads();
        }
    }
}

struct NormRow { f32x4 x[4]; u32x2 t[4]; float ps; };
template <bool SECOND> __device__ __forceinline__ void norm_load(const Ctx& F, int m, int lane, NormRow& r) {
    const f32x4* xr = (const f32x4*)(SECOND ? F.out + (size_t)m * D : xrow(F, m)) + lane; const u32x2* tr = (const u32x2*)((SECOND ? F.FO : F.T) + (size_t)m * D) + lane;
#pragma unroll
    for (int j = 0; j < 4; ++j) { r.x[j] = xr[64 * j]; r.t[j] = tr[64 * j]; }
    r.ps = F.PS[(size_t)m * 16 + (lane & 15)];
}
template <bool SECOND> __device__ __forceinline__ void norm_rows(const Ctx& F) {
    const int gw = F.vcu * NWAVES + F.wave, NGW = F.G * NWAVES, lane = F.lane;
    const float* gpost = SECOND ? F.g_ffn_post : F.g_mix_post;
    f32x4 gv[4];
#pragma unroll
    for (int j = 0; j < 4; ++j) gv[j] = ((const f32x4*)gpost)[64 * j + lane];
    NormRow cur, nxt;
    if (gw < M) norm_load<SECOND>(F, gw, lane, cur);
#pragma unroll 1
    for (int m = gw; m < M; m += NGW) {
        nxt = cur;
        if (m + NGW < M) norm_load<SECOND>(F, m + NGW, lane, nxt);
        float ss = cur.ps;
        ss += __shfl_xor(ss, 1); ss += __shfl_xor(ss, 2); ss += __shfl_xor(ss, 4); ss += __shfl_xor(ss, 8);
        const float rstdT = 1.0f / sqrtf(ss * (1.f / D) + EPS);
        f32x4 v[4]; float s2 = 0.f;
#pragma unroll
        for (int j = 0; j < 4; ++j) { const f32x4 xv = cur.x[j]; const u32x2 t = cur.t[j];
            v[j].x = xv.x + bflo(t.x) * rstdT * gv[j].x; v[j].y = xv.y + bfhi(t.x) * rstdT * gv[j].y; v[j].z = xv.z + bflo(t.y) * rstdT * gv[j].z; v[j].w = xv.w + bfhi(t.y) * rstdT * gv[j].w;
            s2 += (v[j].x * v[j].x + v[j].y * v[j].y) + (v[j].z * v[j].z + v[j].w * v[j].w); }
        f32x4* orow = (f32x4*)(F.out + (size_t)m * D) + lane;
#pragma unroll
        for (int j = 0; j < 4; ++j) orow[64 * j] = v[j];
        if (!SECOND) {
            const float rstd = 1.0f / sqrtf(wave_sum(s2) * (1.f / D) + EPS);
            unsigned long long* o8 = (unsigned long long*)(F.H2 + (size_t)m * D) + lane;
#pragma unroll
            for (int j = 0; j < 4; ++j) o8[64 * j] = (unsigned long long)pk2(v[j].x * rstd, v[j].y * rstd) | ((unsigned long long)pk2(v[j].z * rstd, v[j].w * rstd) << 32);
        }
        cur = nxt;
    }
}

#define REP_P0 1
#define REP_P2 1
#define REP_P4 1
#define REP_G 1
__global__ void __launch_bounds__(NTHR, 2) enc_fwd(Args args) {
    extern __shared__ __attribute__((aligned(16))) unsigned char lds[];
    cg::grid_group grid = cg::this_grid();
    Ctx F;
    F.lds = (LAS unsigned char*)lds;
    F.tid = threadIdx.x; F.lane = F.tid & 63; F.wave = __builtin_amdgcn_readfirstlane(F.tid >> 6);
    F.G = gridDim.x; { const int bx = blockIdx.x; F.vcu = (F.G % 8 == 0) ? (bx % 8) * (F.G / 8) + bx / 8 : bx; }
    unsigned char* ws = args.ws;
    F.xp = args.in[0]; F.xs = args.in[1]; F.g_mix_pre = args.in[2]; F.w_in = args.in[3]; F.w_grp = args.in[4]; F.pool_scale = args.in[5]; F.rpb = args.in[6]; F.w_out = args.in[7];
    F.g_mix_post = args.in[8]; F.g_ffn_pre = args.in[9]; F.w_gu = args.in[10]; F.w_down = args.in[11]; F.g_ffn_post = args.in[12]; F.out = args.out;
    F.W1t = (bf16*)(ws + WS_W1); F.Wvt = (bf16*)(ws + WS_WV); F.W2t = (bf16*)(ws + WS_W2); F.W3t = (bf16*)(ws + WS_W3); F.W4t = (bf16*)(ws + WS_W4); F.PS = (float*)(ws + WS_PS);
    F.XN = (bf16*)(ws + WS_XN); F.MX = F.XN; F.FO = F.XN; F.Z = (bf16*)(ws + WS_Z); F.ACT = F.Z; F.H2 = (bf16*)(ws + WS_H2); F.VT = (bf16*)(ws + WS_VT); F.T = F.VT;
    const int lo = args.ph_lo, hi = args.ph_hi;
#define IN(k) (lo <= (k) && (k) < hi)
#define SEAM(k) do { if (IN(k) && IN((k) + 1)) grid.sync(); } while (0)
#define REPEAT(n) for (int rep_ = 0; rep_ < (n); ++rep_, ((rep_ < (n)) ? grid.sync() : (void)0))
    if (IN(0)) { REPEAT(REP_P0) p0_prologue(F); } SEAM(0);
    if (IN(1)) { REPEAT(REP_G) {
        { pg8::Gemm g{F.XN, F.W1t, M, NZ, D}; pg8::StaticOrder S; S.init(M, NZ, F.G, (int)blockIdx.x); pg8::EpiPlain E{F.Z, NZ};
          pg8::gemm_phase<pg8::EpiPlain, pg8::StaticOrder, true, true>(F.lds, g, S, E); }
        { pg8::Gemm g{F.Wvt, F.XN, D, M, D}; pg8::StaticOrder S; S.init(D, M, F.G, (int)blockIdx.x); pg8::EpiPlain E{F.VT, M};
          pg8::gemm_phase<pg8::EpiPlain, pg8::StaticOrder, true, true>(F.lds, g, S, E); } }
    } SEAM(1);
    if (IN(2)) { REPEAT(REP_P2) pool_phase(F); } SEAM(2);
    if (IN(3)) { attn_phase(F); } SEAM(3);
    if (IN(4)) { REPEAT(REP_G) { pg8::Gemm g{F.MX, F.W2t, M, D, D}; pg8::StaticOrder S; S.init(M, D, F.G, (int)blockIdx.x); pg8::EpiSumsq E{F.T, D, F.PS};
        pg8::gemm_phase<pg8::EpiSumsq, pg8::StaticOrder, true, true>(F.lds, g, S, E); } } SEAM(4);
    if (IN(5)) { REPEAT(REP_P4) norm_rows<false>(F); } SEAM(5);
    if (IN(6)) { REPEAT(REP_G) { pg8::Gemm g{F.H2, F.W3t, M, 2 * DFF, D}; pg8::StaticOrder S; S.init(M, 2 * DFF, F.G, (int)blockIdx.x); pg8::EpiSwiglu E{F.ACT, DFF};
        pg8::gemm_phase<pg8::EpiSwiglu, pg8::StaticOrder, true, true>(F.lds, g, S, E); } } SEAM(6);
    if (IN(7)) { REPEAT(REP_G) { pg8::Gemm g{F.ACT, F.W4t, M, D, DFF}; pg8::StaticOrder S; S.init(M, D, F.G, (int)blockIdx.x); pg8::EpiSumsq E{F.FO, D, F.PS};
        pg8::gemm_phase<pg8::EpiSumsq, pg8::StaticOrder, true, true>(F.lds, g, S, E); } } SEAM(7);
    if (IN(8)) { norm_rows<true>(F); }
#undef REPEAT
#undef IN
#undef SEAM
}

#ifndef MK_PER_PHASE
#define MK_PER_PHASE 0
#endif
extern "C" void kernel_launch(void* const* d_in, const int* in_sizes, int n_in, void* d_out, int out_size, void* d_ws, size_t ws_size, hipStream_t stream) {
    static int grid = 0;
    if (grid == 0) {
        if (n_in != 13 || out_size != M * D || ws_size < WS_END) { fprintf(stderr, "kernel_launch: unexpected problem (n_in %d, out %d, ws %zu); nothing launched\n", n_in, out_size, ws_size); grid = -1; return; }
        int dev = 0, cus = 0, per_cu = 0;
        if (hipGetDevice(&dev) != hipSuccess || hipDeviceGetAttribute(&cus, hipDeviceAttributeMultiprocessorCount, dev) != hipSuccess) { grid = -1; return; }
        if (hipFuncSetAttribute((const void*)enc_fwd, hipFuncAttributeMaxDynamicSharedMemorySize, LDS_BYTES) != hipSuccess) { fprintf(stderr, "kernel_launch: hipFuncSetAttribute failed\n"); grid = -1; return; }
        if (hipOccupancyMaxActiveBlocksPerMultiprocessor(&per_cu, (const void*)enc_fwd, NTHR, LDS_BYTES) != hipSuccess || per_cu < 1) { fprintf(stderr, "kernel_launch: occupancy query says %d\n", per_cu); per_cu = 1; }
        (void)hipGetLastError();
        grid = cus;
    }
    if (grid < 0) return;
    Args a{};
    for (int i = 0; i < 13; ++i) a.in[i] = (const float*)d_in[i];
    a.out = (float*)d_out; a.ws = (unsigned char*)d_ws;
#if MK_PER_PHASE
    for (int p = 0; p < 9; ++p) { a.ph_lo = p; a.ph_hi = p + 1; hipLaunchKernelGGL(enc_fwd, dim3(grid), dim3(NTHR), LDS_BYTES, stream, a); }
#else
    a.ph_lo = 0; a.ph_hi = 9;
    void* kargs[] = {&a};
    const hipError_t e = hipLaunchCooperativeKernel((const void*)enc_fwd, dim3(grid), dim3(NTHR), kargs, LDS_BYTES, stream);
    if (e != hipSuccess) fprintf(stderr, "kernel_launch: cooperative launch failed: %s (grid %d)\n", hipGetErrorString(e), grid);
#endif
}
```

```cpp
#include <hip/hip_runtime.h>
#include <hip/hip_cooperative_groups.h>
#include <cstdio>
#include <cstdint>
namespace cg = cooperative_groups;
namespace pg8 {
#define PG8_LAS __attribute__((address_space(3)))
typedef unsigned short bf16_t;
typedef short bf16x8 __attribute__((ext_vector_type(8)));
typedef float f32x4 __attribute__((ext_vector_type(4)));
typedef unsigned u32x4 __attribute__((ext_vector_type(4)));
constexpr int BM = 256, BK = 64, HALF = 128, HTB = HALF * BK * 2  , STAGE_BYTES = 8 * HTB, NXCD = 8, WGM = 8;

__host__ __device__ __forceinline__ int lds_byte(int r, int c) { const int st = (r >> 4) * 2 + (c >> 5), rr = r & 15, cc = c & 31, ob = rr * 64 + cc * 2; return st * 1024 + (ob ^ (((ob >> 9) & 1) << 5)); }
__host__ __device__ __forceinline__ void stage_rc(int b, int& R, int& C) { const int st = b / 1024, sb = b % 1024, swz = sb ^ (((sb >> 9) & 1) << 5); R = (st >> 1) * 16 + swz / 64; C = (st & 1) * 32 + (swz % 64) / 2; }
__host__ __device__ __forceinline__ int perm32(int rho) { const int n = rho >> 4, i = rho & 15; return 8 * (i >> 2) + 4 * n + (i & 3); }

struct Unit { int pm, pn; };
struct Gemm { const bf16_t* A; const bf16_t* Bt; int M, N, K; };

struct StaticOrder {
    int nM, nN, nwg, G, c;
    __host__ __device__ void init(int M, int N, int G_, int c_) { nM = M / BM; nN = N / BM; nwg = nM * nN; G = G_; c = c_; }
    __host__ __device__ bool next(int i, Unit& u) const {
        const long L = (long)i * G + c; if (L >= nwg) return false;
        int wgid = (int)L; { const int q = nwg / NXCD, r = nwg % NXCD, xcd = wgid % NXCD, off = wgid / NXCD; wgid = (xcd < r ? xcd * (q + 1) : r * (q + 1) + (xcd - r) * q) + off; }
        const int nig = WGM * nN, gid = wgid / nig, fm = gid * WGM, gsz = (nM - fm) < WGM ? (nM - fm) : WGM;
        u.pm = fm + ((wgid % nig) % gsz); u.pn = (wgid % nig) / gsz; return true;
    }
    __device__ __forceinline__ void a_ready(const Unit&) const {}
    __device__ __forceinline__ void done(const Unit&) const {}
};

__device__ __forceinline__ unsigned cvt_pk_bf16(float lo, float hi) { unsigned r; asm volatile("v_cvt_pk_bf16_f32 %0, %1, %2" : "=v"(r) : "v"(lo), "v"(hi)); return r; }
typedef float f32x2 __attribute__((ext_vector_type(2)));
__device__ __forceinline__ float fast_sigmoid(float v) { return __builtin_amdgcn_rcpf(1.0f + __expf(-v)); }
struct EpiPlain {
    static constexpr bool PERM = true, AFTER_DRAIN = false;
    bf16_t* O; int ldc;
    __device__ __forceinline__ void operator()(const f32x4 (&acc)[2][2][4][2], const Unit& u, int wr, int wc, int fr, int fq) const {
        const int row0 = u.pm * BM + wr * 64 + fr, col0 = u.pn * BM + wc * 32 + 8 * fq;
#pragma unroll
        for (int ai = 0; ai < 2; ++ai)
#pragma unroll
            for (int m = 0; m < 4; ++m) { bf16_t* rowp = O + (size_t)(row0 + ai * HALF + m * 16) * ldc + col0;
#pragma unroll
                for (int bj = 0; bj < 2; ++bj) { const f32x4 v0 = acc[ai][bj][m][0], v1 = acc[ai][bj][m][1];
                    u32x4 w; w.x = cvt_pk_bf16(v0[0], v0[1]); w.y = cvt_pk_bf16(v0[2], v0[3]); w.z = cvt_pk_bf16(v1[0], v1[1]); w.w = cvt_pk_bf16(v1[2], v1[3]);
                    *(u32x4*)(rowp + bj * HALF) = w; } }
    }
};
struct EpiSumsq {
    static constexpr bool PERM = true, AFTER_DRAIN = false;
    bf16_t* O; int ldc; float* ps;
    __device__ __forceinline__ void operator()(const f32x4 (&acc)[2][2][4][2], const Unit& u, int wr, int wc, int fr, int fq) const {
        const int row0 = u.pm * BM + wr * 64 + fr, col0 = u.pn * BM + wc * 32 + 8 * fq;
#pragma unroll
        for (int ai = 0; ai < 2; ++ai)
#pragma unroll
            for (int m = 0; m < 4; ++m) { const int row = row0 + ai * HALF + m * 16; bf16_t* rowp = O + (size_t)row * ldc + col0; float s = 0.f;
#pragma unroll
                for (int bj = 0; bj < 2; ++bj) { const f32x4 v0 = acc[ai][bj][m][0], v1 = acc[ai][bj][m][1];
                    s += (v0[0] * v0[0] + v0[1] * v0[1]) + (v0[2] * v0[2] + v0[3] * v0[3]) + (v1[0] * v1[0] + v1[1] * v1[1]) + (v1[2] * v1[2] + v1[3] * v1[3]);
                    u32x4 w; w.x = cvt_pk_bf16(v0[0], v0[1]); w.y = cvt_pk_bf16(v0[2], v0[3]); w.z = cvt_pk_bf16(v1[0], v1[1]); w.w = cvt_pk_bf16(v1[2], v1[3]);
                    *(u32x4*)(rowp + bj * HALF) = w; }
                s += __shfl_xor(s, 16); s += __shfl_xor(s, 32);
                if (fq == 0) ps[(size_t)row * 16 + u.pn * 4 + wc] = s; }
    }
};
struct EpiSwiglu {
    static constexpr bool PERM = true, AFTER_DRAIN = false;
    bf16_t* O; int ldc;
    __device__ __forceinline__ void operator()(const f32x4 (&acc)[2][2][4][2], const Unit& u, int wr, int wc, int fr, int fq) const {
        const int row0 = u.pm * BM + wr * 64 + fr, col0 = u.pn * HALF + wc * 32 + 8 * fq;
#pragma unroll
        for (int ai = 0; ai < 2; ++ai)
#pragma unroll
            for (int m = 0; m < 4; ++m) { bf16_t* rowp = O + (size_t)(row0 + ai * HALF + m * 16) * ldc + col0;
                float a[8];
#pragma unroll
                for (int n = 0; n < 2; ++n)
#pragma unroll
                    for (int e = 0; e < 4; ++e) { const float gt = acc[ai][0][m][n][e], up = acc[ai][1][m][n][e]; a[4 * n + e] = gt * fast_sigmoid(gt) * up; }
                u32x4 w; w.x = cvt_pk_bf16(a[0], a[1]); w.y = cvt_pk_bf16(a[2], a[3]); w.z = cvt_pk_bf16(a[4], a[5]); w.w = cvt_pk_bf16(a[6], a[7]);
                *(u32x4*)rowp = w; }
    }
};
template <class Epi, class Sched, bool ALIGN_EPI = false, bool SP2 = false>
__device__ __forceinline__ void gemm_phase(PG8_LAS unsigned char* lds, const Gemm g, const Sched& S, const Epi& E) {
    const int tid = threadIdx.x, wid = __builtin_amdgcn_readfirstlane(tid >> 6), lane = tid & 63, wr = wid >> 2, wc = wid & 3, fr = lane & 15, fq = lane >> 4;
    const int K = g.K, nt = K / BK;
    unsigned voffA[2], voffB[2];
#pragma unroll
    for (int i = 0; i < 2; ++i) { int R, C; stage_rc(tid * 16 + i * 8192, R, C); const int Rb = Epi::PERM ? ((R & ~31) + perm32(R & 31)) : R;
        voffA[i] = (unsigned)(R * K + C) * 2u; voffB[i] = (unsigned)(Rb * K + C) * 2u; }
    const size_t kstep = (size_t)(BK * 2);
    const size_t hstep = (size_t)HALF * K * 2;
    const size_t tstep = 2 * hstep;
    const unsigned ldsw = (unsigned)wid * 1024u;
    const int aoff = lds_byte(wr * 64 + fr, fq * 8), boff = lds_byte(wc * 32 + fr, fq * 8);
#define PG8_SA(b, h) (((b) * 2 + (h)) * HTB)
#define PG8_SB(b, h) ((4 + (b) * 2 + (h)) * HTB)
#define PG8_STAGE(bufoff, gbase, voff) do { _Pragma("unroll") for (int _i = 0; _i < 2; ++_i) \
        __builtin_amdgcn_global_load_lds((const unsigned*)((const char*)(gbase) + (voff)[_i]), (PG8_LAS unsigned*)(lds + (bufoff) + ldsw + _i * 8192), 16, 0, 0); } while (0)
#define PG8_LDA(dst, b, h) do { _Pragma("unroll") for (int m = 0; m < 4; ++m) _Pragma("unroll") for (int k = 0; k < 2; ++k) dst[m][k] = *(const PG8_LAS bf16x8*)(lds + PG8_SA(b, h) + aoff + m * 2048 + k * 1024); } while (0)
#define PG8_LDB(dst, b, h) do { _Pragma("unroll") for (int n = 0; n < 2; ++n) _Pragma("unroll") for (int k = 0; k < 2; ++k) dst[n][k] = *(const PG8_LAS bf16x8*)(lds + PG8_SB(b, h) + boff + n * 2048 + k * 1024); } while (0)
#define PG8_MMA(ai, bj, At, Bt) do { __builtin_amdgcn_s_setprio(1); _Pragma("unroll") for (int m = 0; m < 4; ++m) _Pragma("unroll") for (int n = 0; n < 2; ++n) _Pragma("unroll") for (int k = 0; k < 2; ++k) \
        acc[ai][bj][m][n] = __builtin_amdgcn_mfma_f32_16x16x32_bf16(Bt[n][k], At[m][k], acc[ai][bj][m][n], 0, 0, 0); __builtin_amdgcn_s_setprio(0); } while (0)
#define PG8_WAIT_V(n) asm volatile("s_waitcnt vmcnt(" #n ")" ::: "memory")
#define PG8_WAIT_L(n) asm volatile("s_waitcnt lgkmcnt(" #n ")" ::: "memory")
#define PG8_BAR __builtin_amdgcn_s_barrier()
#define PG8_SCHED __builtin_amdgcn_sched_barrier(0)
    Unit cur, nxt; int ui = 0;
    if (!S.next(0, cur)) return;
    f32x4 acc[2][2][4][2];
#pragma unroll
    for (int a = 0; a < 2; ++a)
#pragma unroll
        for (int b = 0; b < 2; ++b)
#pragma unroll
            for (int m = 0; m < 4; ++m)
#pragma unroll
                for (int n = 0; n < 2; ++n) acc[a][b][m][n] = (f32x4){0.f, 0.f, 0.f, 0.f};
    bf16x8 At[4][2], B0[2][2], B1[2][2];
    const char* cA = (const char*)g.A + (size_t)cur.pm * tstep; const char* cB = (const char*)g.Bt + (size_t)cur.pn * tstep;
    S.a_ready(cur);
    if constexpr (SP2) {
        PG8_STAGE(PG8_SB(0, 0), cB, voffB); PG8_STAGE(PG8_SB(0, 1), cB + hstep, voffB); PG8_STAGE(PG8_SA(0, 0), cA, voffA); PG8_STAGE(PG8_SA(0, 1), cA + hstep, voffA);
        if (wr == 1) PG8_BAR;
        PG8_WAIT_V(2); PG8_BAR;
        PG8_STAGE(PG8_SB(1, 0), cB + kstep, voffB); PG8_STAGE(PG8_SA(1, 0), cA + kstep, voffA); PG8_STAGE(PG8_SB(1, 1), cB + hstep + kstep, voffB);
        PG8_WAIT_V(6); PG8_BAR;
    } else {
        PG8_STAGE(PG8_SB(0, 0), cB, voffB); PG8_STAGE(PG8_SA(0, 0), cA, voffA); PG8_STAGE(PG8_SB(0, 1), cB + hstep, voffB); PG8_STAGE(PG8_SA(0, 1), cA + hstep, voffA);
        if (wr == 1) PG8_BAR;
        PG8_WAIT_V(4); PG8_BAR;
        PG8_STAGE(PG8_SB(1, 0), cB + kstep, voffB); PG8_STAGE(PG8_SA(1, 0), cA + kstep, voffA); PG8_STAGE(PG8_SB(1, 1), cB + hstep + kstep, voffB);
        PG8_WAIT_V(6); PG8_BAR;
    }
    for (;;) {
        const bool has_next = S.next(ui + 1, nxt);
        const char* nA = has_next ? (const char*)g.A + (size_t)nxt.pm * tstep : cA; const char* nB = has_next ? (const char*)g.Bt + (size_t)nxt.pn * tstep : cB;
        for (int t = 0; t < nt; t += 2) {
            const bool last = (t == nt - 2);
            const char* a1 = cA + (size_t)(t + 1) * kstep;
            const char* a2 = last ? nA : cA + (size_t)(t + 2) * kstep; const char* b2 = last ? nB : cB + (size_t)(t + 2) * kstep;
            const char* a3 = a2 + kstep; const char* b3 = b2 + kstep;
            if (last && has_next) S.a_ready(nxt);
            if constexpr (SP2) {
            PG8_LDB(B0, 0, 0); PG8_LDB(B1, 0, 1); PG8_SCHED; PG8_LDA(At, 0, 0); PG8_STAGE(PG8_SA(1, 1), a1 + hstep, voffA);
            PG8_WAIT_V(8); PG8_WAIT_L(0); PG8_BAR; PG8_MMA(0, 0, At, B0); PG8_MMA(0, 1, At, B1); PG8_BAR; PG8_SCHED;
            PG8_LDA(At, 0, 1); PG8_STAGE(PG8_SB(0, 0), b2, voffB); PG8_STAGE(PG8_SB(0, 1), b2 + hstep, voffB); PG8_STAGE(PG8_SA(0, 0), a2, voffA);
            PG8_WAIT_V(8); PG8_WAIT_L(0); PG8_BAR; PG8_MMA(1, 0, At, B0); PG8_MMA(1, 1, At, B1); PG8_BAR; PG8_SCHED;
            PG8_LDB(B0, 1, 0); PG8_LDB(B1, 1, 1); PG8_SCHED; PG8_LDA(At, 1, 0); PG8_STAGE(PG8_SA(0, 1), a2 + hstep, voffA);
            PG8_WAIT_V(8); PG8_WAIT_L(0); PG8_BAR; PG8_MMA(0, 0, At, B0); PG8_MMA(0, 1, At, B1); PG8_BAR; PG8_SCHED;
            PG8_LDA(At, 1, 1); PG8_STAGE(PG8_SB(1, 0), b3, voffB); PG8_STAGE(PG8_SB(1, 1), b3 + hstep, voffB); PG8_STAGE(PG8_SA(1, 0), a3, voffA);
            PG8_WAIT_V(8); PG8_WAIT_L(0); PG8_BAR; PG8_MMA(1, 0, At, B0); PG8_MMA(1, 1, At, B1); PG8_BAR; PG8_SCHED;
            } else {
            PG8_LDB(B0, 0, 0); PG8_SCHED; PG8_LDA(At, 0, 0); PG8_STAGE(PG8_SA(1, 1), a1 + hstep, voffA);
            PG8_WAIT_L(8); PG8_BAR; PG8_WAIT_L(0); PG8_MMA(0, 0, At, B0); PG8_BAR; PG8_SCHED;
            PG8_LDB(B1, 0, 1); PG8_STAGE(PG8_SB(0, 0), b2, voffB);
            PG8_BAR; PG8_WAIT_L(0); PG8_MMA(0, 1, At, B1); PG8_BAR;
            PG8_LDA(At, 0, 1); PG8_STAGE(PG8_SA(0, 0), a2, voffA);
            PG8_BAR; PG8_WAIT_L(0); PG8_MMA(1, 0, At, B0); PG8_BAR; PG8_SCHED;
            PG8_STAGE(PG8_SB(0, 1), b2 + hstep, voffB);
            PG8_WAIT_V(6); PG8_BAR; PG8_MMA(1, 1, At, B1); PG8_BAR;
            PG8_LDB(B0, 1, 0); PG8_SCHED; PG8_LDA(At, 1, 0); PG8_STAGE(PG8_SA(0, 1), a2 + hstep, voffA);
            PG8_WAIT_L(8); PG8_BAR; PG8_WAIT_L(0); PG8_MMA(0, 0, At, B0); PG8_BAR; PG8_SCHED;
            PG8_LDB(B1, 1, 1); PG8_STAGE(PG8_SB(1, 0), b3, voffB);
            PG8_BAR; PG8_WAIT_L(0); PG8_MMA(0, 1, At, B1); PG8_BAR;
            PG8_LDA(At, 1, 1); PG8_STAGE(PG8_SA(1, 0), a3, voffA);
            PG8_BAR; PG8_WAIT_L(0); PG8_MMA(1, 0, At, B0); PG8_BAR; PG8_SCHED;
            PG8_STAGE(PG8_SB(1, 1), b3 + hstep, voffB);
            PG8_WAIT_V(6); PG8_BAR; PG8_MMA(1, 1, At, B1); PG8_BAR;
            }
        }
        if constexpr (ALIGN_EPI) { if (wr == 0) PG8_BAR; }
        if constexpr (!Epi::AFTER_DRAIN) { E(acc, cur, wr, wc, fr, fq); S.done(cur); }
        if (!has_next) break;
#pragma unroll
        for (int a = 0; a < 2; ++a)
#pragma unroll
            for (int b = 0; b < 2; ++b)
#pragma unroll
                for (int m = 0; m < 4; ++m)
#pragma unroll
                    for (int n = 0; n < 2; ++n) acc[a][b][m][n] = (f32x4){0.f, 0.f, 0.f, 0.f};
        cur = nxt; cA = nA; cB = nB; ++ui;
        if constexpr (ALIGN_EPI) { if (wr == 1) PG8_BAR; }
    }
    PG8_WAIT_V(0);
    if constexpr (!ALIGN_EPI) { if (wr == 0) PG8_BAR; }
    PG8_BAR;
    if constexpr (Epi::AFTER_DRAIN) { E.fused(acc, cur, wr, wc, fr, fq, lds, wid, lane); S.done(cur); }
#undef PG8_SA
#undef PG8_SB
#undef PG8_STAGE
#undef PG8_LDA
#undef PG8_LDB
#undef PG8_MMA
#undef PG8_WAIT_V
#undef PG8_WAIT_L
#undef PG8_BAR
#undef PG8_SCHED
}
}
constexpr int NWAVES = 8, NTHR = NWAVES * 64;
constexpr int D = 1024, SEQ = 8192, NBATCH = 10, M = NBATCH * SEQ, MP = 2 * SEQ;
constexpr int DIN = 4608, DFF = 2816, NZ = 4096;
constexpr int ZQ = 1024, ZK = 1536, ZGP = 2048, ZGA = 3072;
constexpr int GRID_W = 64, GRID_H = SEQ / GRID_W;
constexpr float EPS = 1e-6f;
constexpr size_t MiB = 1u << 20;
constexpr size_t WS_W1 = 1 * MiB, WS_WV = 9 * MiB, WS_W2 = 11 * MiB, WS_W3 = 13 * MiB, WS_W4 = 24 * MiB, WS_PS = 30 * MiB;
constexpr size_t WS_XN = 36 * MiB;
constexpr size_t WS_Z = 196 * MiB;
constexpr size_t WS_H2 = WS_Z + 440 * MiB;
constexpr size_t WS_VT = 836 * MiB;
constexpr size_t WS_END = 996 * MiB;
static_assert(WS_W4 + (size_t)D * DFF * 2 <= WS_PS && WS_PS + (size_t)M * 16 * 4 <= WS_XN && WS_XN + (size_t)M * D * 2 <= WS_Z && WS_Z + (size_t)M * NZ * 2 <= WS_VT &&
              (size_t)M * DFF * 2 <= 440 * MiB && WS_H2 + (size_t)M * D * 2 <= WS_VT && WS_VT + (size_t)M * D * 2 <= WS_END, "d_ws map");
constexpr int PA_STRIDE = 2080;
constexpr int PA_BYTES = 64 * PA_STRIDE;
constexpr int RPB_N = 8 * 15 * 31;
constexpr int LDS_BYTES = 155648;
static_assert(pg8::STAGE_BYTES <= LDS_BYTES, "LDS map");

#define LAS __attribute__((address_space(3)))
typedef unsigned short bf16;
typedef float f32x4 __attribute__((ext_vector_type(4)));
typedef short bf16x8 __attribute__((ext_vector_type(8)));
typedef unsigned u32x2 __attribute__((ext_vector_type(2)));
typedef unsigned u32x4 __attribute__((ext_vector_type(4)));
#define LDS_WAIT() asm volatile("s_waitcnt lgkmcnt(0)" ::: "memory")
__device__ __forceinline__ unsigned f2bf(float f) { unsigned u = __builtin_bit_cast(unsigned, f); return (u + 0x7fffu + ((u >> 16) & 1u)) >> 16; }
__device__ __forceinline__ unsigned pk2(float lo, float hi) { return f2bf(lo) | (f2bf(hi) << 16); }
__device__ __forceinline__ float bflo(unsigned w) { return __uint_as_float(w << 16); }
__device__ __forceinline__ float bfhi(unsigned w) { return __uint_as_float(w & 0xffff0000u); }
__device__ __forceinline__ float sigm(float v) { return __builtin_amdgcn_rcpf(1.0f + __expf(-v)); }
__device__ __forceinline__ float wave_sum(float v) {
#pragma unroll
    for (int o = 1; o < 64; o <<= 1) v += __shfl_xor(v, o);
    return v;
}

constexpr size_t WS_CTL = 0, CTL_ZERO_BYTES = 512 * 1024;
constexpr int CW_BAR = 0, CW_SEAM = 4096, SEAM_BANK = 320 * 64;
constexpr int MISC_OFF = LDS_BYTES - 64;
#define XB_TMO      128
#define XB_XCNT(j)  (256  + 64 * (j))
#define XB_XSUB(j)  (1280 + 64 * (j))
#define XB_XGEN(j)  (2304 + 64 * (j))
#define XB_TOP      3328
#define XB_TOPGEN   3392
#define XCD_BAR_WORDS 3456
#define XB_SPIN_CAP (1u << 18)

__device__ __forceinline__ unsigned xb_ld(unsigned* p)              { return __hip_atomic_load(p, __ATOMIC_RELAXED, __HIP_MEMORY_SCOPE_AGENT); }
__device__ __forceinline__ unsigned xb_add(unsigned* p, unsigned v) { return __hip_atomic_fetch_add(p, v, __ATOMIC_RELAXED, __HIP_MEMORY_SCOPE_AGENT); }
__device__ __forceinline__ unsigned xb_xcc_id() { return (unsigned)__builtin_amdgcn_s_getreg((3 << 11) | 20) & 0xFu; }
#define XB_SPIN(cond, bar) do { unsigned _sp = 0; while (cond) { __builtin_amdgcn_s_sleep(1); \
    if ((++_sp & 255u) == 0u) { if (xb_ld(&(bar)[XB_TMO])) break; if (_sp > XB_SPIN_CAP) { atomicAdd(&(bar)[XB_TMO], 1u); break; } } } } while (0)

struct XcdBarrier {
    unsigned* bar; unsigned x;
    volatile LAS unsigned* st;
};

__device__ __forceinline__ XcdBarrier xcd_barrier_post(unsigned* bar, volatile LAS unsigned* st) {
    XcdBarrier b; b.bar = bar; b.x = xb_xcc_id(); b.st = st;
    if (threadIdx.x == 0) (void)xb_add(&bar[XB_XCNT(b.x)], 1u);
    return b;
}
__device__ __forceinline__ void xcd_barrier_complete(unsigned* bar, unsigned x, unsigned& nloc, unsigned& nx) {
    const unsigned G = gridDim.x * gridDim.y * gridDim.z;
    unsigned sum, cnt, mine, sp = 0u;
    for (;;) {
        sum = 0u; cnt = 0u; mine = 0u;
#pragma unroll
        for (unsigned j = 0; j < 16; ++j) { const unsigned c = xb_ld(&bar[XB_XCNT(j)]); sum += c; cnt += (c > 0u) ? 1u : 0u; mine = (j == x) ? c : mine; }
        if (sum == G) break;
        __builtin_amdgcn_s_sleep(1);
        if ((++sp & 255u) == 0u) { if (xb_ld(&bar[XB_TMO])) break; if (sp > XB_SPIN_CAP) { atomicAdd(&bar[XB_TMO], 1u); break; } }
    }
    nloc = mine > 0u ? mine : 1u; nx = cnt > 0u ? cnt : 1u;
}

__device__ __forceinline__ void xcd_barrier(const XcdBarrier& b) {
    asm volatile("s_waitcnt vmcnt(0)" ::: "memory");
    __syncthreads();
    if (threadIdx.x == 0) {
        unsigned* bar = b.bar;
        __builtin_amdgcn_s_waitcnt(0);
        unsigned nloc = b.st[0], nx = b.st[1];
        if (nloc == 0u) { xcd_barrier_complete(bar, b.x, nloc, nx); b.st[0] = nloc; b.st[1] = nx; }
        const unsigned old = xb_add(&bar[XB_XSUB(b.x)], 1u);
        const unsigned gen = old / nloc;
        if (old + 1u == (gen + 1u) * nloc) {
            __builtin_amdgcn_fence(__ATOMIC_RELEASE, "agent");
            asm volatile("s_waitcnt vmcnt(0)" ::: "memory");
            const unsigned og = xb_add(&bar[XB_TOP], 1u);
            const unsigned tg = og / nx;
            if (og + 1u == (tg + 1u) * nx) xb_add(&bar[XB_TOPGEN], 1u);
            else XB_SPIN(xb_ld(&bar[XB_TOPGEN]) == tg, bar);
            __builtin_amdgcn_fence(__ATOMIC_ACQUIRE, "agent");
            xb_add(&bar[XB_XGEN(b.x)], 1u);
            asm volatile("s_waitcnt vmcnt(0)" ::: "memory");
        } else {
            XB_SPIN(xb_ld(&bar[XB_XGEN(b.x)]) == gen, bar);
            __builtin_amdgcn_fence(__ATOMIC_ACQUIRE, "agent");
            asm volatile("s_waitcnt vmcnt(0)" ::: "memory");
        }
    }
    __syncthreads();
}

struct Args { const float* in[13]; float* out; unsigned char* ws; int ph_lo, ph_hi; };
struct Ctx {
    LAS unsigned char* lds; int tid, lane, wave, vcu, G;
    const float *xp, *xs, *g_mix_pre, *w_in, *w_grp, *pool_scale, *rpb, *w_out, *g_mix_post, *g_ffn_pre, *w_gu, *w_down, *g_ffn_post;
    float* out; bf16 *W1t, *Wvt, *W2t, *W3t, *W4t, *XN, *Z, *VT, *MX, *T, *H2, *ACT, *FO; float* PS;
};
__device__ __forceinline__ const float* xrow(const Ctx& F, int m) { return m < MP ? F.xp + (size_t)m * D : F.xs + (size_t)(m - MP) * D; }

__device__ __forceinline__ void tr_item(const float* W, int ldw, int nsrc0, int k0, bf16* WT, int Kdst, int drow0, const float* gain, float mul, LAS float* scr, int lane) {
#pragma unroll 8
    for (int i = 0; i < 32; ++i) { const int kk = 2 * i + (lane >> 5); const float gsc = gain ? gain[k0 + kk] * mul : mul;
        scr[kk * 33 + (lane & 31)] = W[(size_t)(k0 + kk) * ldw + nsrc0 + (lane & 31)] * gsc; }
    LDS_WAIT(); asm volatile("" ::: "memory");
    const int c = lane & 7;
#pragma unroll
    for (int j = 0; j < 4; ++j) { const int n = (lane >> 3) + 8 * j; const LAS float* s = scr + (8 * c) * 33 + n;
        u32x4 o; o.x = pk2(s[0 * 33], s[1 * 33]); o.y = pk2(s[2 * 33], s[3 * 33]); o.z = pk2(s[4 * 33], s[5 * 33]); o.w = pk2(s[6 * 33], s[7 * 33]);
        *(u32x4*)(WT + (size_t)(drow0 + n) * Kdst + k0 + 8 * c) = o; }
    LDS_WAIT(); asm volatile("" ::: "memory");
}
__device__ __forceinline__ void tr_seg(const float* W, int ldw, int nsrc_base, int ncols, bf16* WT, int Kdst, int drow_base, const float* gain, float mul, LAS float* scr, int lane, int item) {
    const int nblk = ncols / 32, kb = item / nblk, nb = item % nblk;
    tr_item(W, ldw, nsrc_base + 32 * nb, 64 * kb, WT, Kdst, drow_base + 32 * nb, gain, mul, scr, lane);
}
__device__ __forceinline__ void fold_item(const Ctx& F, int item, int lane) {
    const int kb = item >> 7, nb = item & 127, grp = nb >> 5, d0 = (nb & 31) * 8, k = kb * 64 + lane;
    const float* a = F.w_in + (size_t)k * DIN + grp * 128; const float* bw = F.w_grp + (size_t)grp * 128 * 256 + d0;
    float acc[8];
#pragma unroll
    for (int e = 0; e < 8; ++e) acc[e] = 0.f;
    for (int c = 0; c < 128; c += 4) { const f32x4 av = *(const f32x4*)(a + c);
#pragma unroll
        for (int cc = 0; cc < 4; ++cc) { const f32x4 b0 = *(const f32x4*)(bw + (size_t)(c + cc) * 256), b1 = *(const f32x4*)(bw + (size_t)(c + cc) * 256 + 4);
            acc[0] += av[cc] * b0[0]; acc[1] += av[cc] * b0[1]; acc[2] += av[cc] * b0[2]; acc[3] += av[cc] * b0[3];
            acc[4] += av[cc] * b1[0]; acc[5] += av[cc] * b1[1]; acc[6] += av[cc] * b1[2]; acc[7] += av[cc] * b1[3]; } }
    const float gk = F.g_mix_pre[k];
#pragma unroll
    for (int e = 0; e < 8; ++e) { const int n = grp * 256 + d0 + e; F.W1t[(size_t)n * D + k] = (bf16)f2bf(acc[e] * gk * F.pool_scale[n]); }
}
__device__ __forceinline__ void rms_row_to_bf16(const float* xr_, bf16* orow, int lane) {
    const f32x4* xr = (const f32x4*)xr_ + lane;
    f32x4 v[4]; float s = 0.f;
#pragma unroll
    for (int j = 0; j < 4; ++j) { v[j] = xr[64 * j]; s += (v[j].x * v[j].x + v[j].y * v[j].y) + (v[j].z * v[j].z + v[j].w * v[j].w); }
    const float rstd = 1.0f / sqrtf(wave_sum(s) * (1.f / D) + EPS);
    unsigned long long* o8 = (unsigned long long*)orow + lane;
#pragma unroll
    for (int j = 0; j < 4; ++j) o8[64 * j] = (unsigned long long)pk2(v[j].x * rstd, v[j].y * rstd) | ((unsigned long long)pk2(v[j].z * rstd, v[j].w * rstd) << 32);
}
__device__ __forceinline__ void p0_prologue(const Ctx& F) {
    LAS float* scr = (LAS float*)(F.lds + F.wave * 16384);
    const int gw = F.vcu * NWAVES + F.wave, NGW = F.G * NWAVES, lane = F.lane;
    constexpr int I_Q = 16 * 16, I_K = 16 * 16, I_G = 16 * 64, I_V = 16 * 32, I_O = 16 * 32, I_GU = 16 * 176, I_DN = 44 * 32, I_FOLD = 16 * 128;
    constexpr int NITEMS = I_Q + I_K + I_G + I_V + I_O + I_GU + I_DN + I_FOLD;
    for (int it = gw; it < NITEMS; it += NGW) {
        int r = it;
        if (r < I_FOLD) { fold_item(F, r, lane); continue; } r -= I_FOLD;
        if (r < I_Q) { tr_seg(F.w_in, DIN, 512, 512, F.W1t, D, ZQ, F.g_mix_pre, 0.125f * 1.4426950408889634f, scr, lane, r); continue; } r -= I_Q;
        if (r < I_K) { tr_seg(F.w_in, DIN, 1024, 512, F.W1t, D, ZK, F.g_mix_pre, 1.f, scr, lane, r); continue; } r -= I_K;
        if (r < I_G) { tr_seg(F.w_in, DIN, 2560, 2048, F.W1t, D, ZGP, F.g_mix_pre, 1.f, scr, lane, r); continue; } r -= I_G;
        if (r < I_V) { tr_seg(F.w_in, DIN, 1536, 1024, F.Wvt, D, 0, F.g_mix_pre, 1.f, scr, lane, r); continue; } r -= I_V;
        if (r < I_O) { tr_seg(F.w_out, D, 0, 1024, F.W2t, D, 0, nullptr, 1.f, scr, lane, r); continue; } r -= I_O;
        if (r < I_GU) {
            const int kb = r / 176, nb = r % 176, nsrc = 32 * nb, isup = nsrc >= DFF, nn = isup ? nsrc - DFF : nsrc;
            tr_item(F.w_gu, 2 * DFF, nsrc, 64 * kb, F.W3t, D, (nn >> 7) * 256 + (nn & 127) + (isup ? 128 : 0), F.g_ffn_pre, 1.f, scr, lane); continue; } r -= I_GU;
        tr_seg(F.w_down, D, 0, 1024, F.W4t, DFF, 0, nullptr, 1.f, scr, lane, r);
    }
    f32x4 cv[4], nv[4];
    if (gw < M) { const f32x4* xr = (const f32x4*)xrow(F, gw) + lane;
#pragma unroll
        for (int j = 0; j < 4; ++j) cv[j] = xr[64 * j]; }
#pragma unroll 1
    for (int m = gw; m < M; m += NGW) {
#pragma unroll
        for (int j = 0; j < 4; ++j) nv[j] = cv[j];
        if (m + NGW < M) { const f32x4* xr = (const f32x4*)xrow(F, m + NGW) + lane;
#pragma unroll
            for (int j = 0; j < 4; ++j) nv[j] = xr[64 * j]; }
        float sq = 0.f;
#pragma unroll
        for (int j = 0; j < 4; ++j) sq += (cv[j].x * cv[j].x + cv[j].y * cv[j].y) + (cv[j].z * cv[j].z + cv[j].w * cv[j].w);
        const float rstd = 1.0f / sqrtf(wave_sum(sq) * (1.f / D) + EPS);
        unsigned long long* o8 = (unsigned long long*)(F.XN + (size_t)m * D) + lane;
#pragma unroll
        for (int j = 0; j < 4; ++j) { o8[64 * j] = (unsigned long long)pk2(cv[j].x * rstd, cv[j].y * rstd) | ((unsigned long long)pk2(cv[j].z * rstd, cv[j].w * rstd) << 32); cv[j] = nv[j]; }
    }
}

template <int HW> struct PoolBuf { unsigned uu[16 + 2 * HW - 1], gp[16]; };
template <int HW> __device__ __forceinline__ void pool_load(const Ctx& F, int q, PoolBuf<HW>& B) {
    const int unit = F.vcu + (q >> 2) * F.G, b = unit >> 7, sb = (unit & 127) * GRID_W + 16 * (q & 3); const bf16* zc = F.Z + (size_t)b * SEQ * NZ + 2 * F.tid;
#pragma unroll
    for (int i = 0; i < 16 + 2 * HW - 1; ++i) { const int j = sb - HW + i, jc = j < 0 ? 0 : (j > SEQ - 1 ? SEQ - 1 : j); const unsigned v = *(const unsigned*)(zc + (size_t)jc * NZ); B.uu[i] = (j == jc) ? v : 0u; }
#pragma unroll
    for (int c = 0; c < 16; ++c) B.gp[c] = *(const unsigned*)(zc + (size_t)(sb + c) * NZ + ZGP);
}
template <int HW> __device__ __forceinline__ void pool_compute(const Ctx& F, int q, const PoolBuf<HW>& B) {
    const int unit = F.vcu + (q >> 2) * F.G, b = unit >> 7, sb = (unit & 127) * GRID_W + 16 * (q & 3); bf16* mo = F.MX + (size_t)b * SEQ * D + 2 * F.tid;
    float sum0 = 0.f, sum1 = 0.f;
#pragma unroll
    for (int i = 0; i < 2 * HW - 1; ++i) { sum0 += bflo(B.uu[i]); sum1 += bfhi(B.uu[i]); }
#pragma unroll
    for (int c = 0; c < 16; ++c) {
        sum0 += bflo(B.uu[c + 2 * HW - 1]); sum1 += bfhi(B.uu[c + 2 * HW - 1]);
        const int s = sb + c, lo = (s - HW) > 0 ? (s - HW) : 0, hi = (s + HW) < SEQ ? (s + HW) : SEQ; const float inv = 1.0f / (float)(hi - lo);
        const float o0 = (sum0 * inv - bflo(B.uu[c + HW])) * sigm(bflo(B.gp[c])), o1 = (sum1 * inv - bfhi(B.uu[c + HW])) * sigm(bfhi(B.gp[c]));
        *(unsigned*)(mo + (size_t)s * D) = pk2(o0, o1);
        sum0 -= bflo(B.uu[c]); sum1 -= bfhi(B.uu[c]);
    }
}
template <int HW> __device__ __forceinline__ void pool_stream(const Ctx& F) {
    const int nun = NBATCH * GRID_H, nq = F.vcu < nun ? 4 * ((nun - F.vcu + F.G - 1) / F.G) : 0;
    if (nq == 0) return;
    PoolBuf<HW> A, B;
    pool_load<HW>(F, 0, A);
#pragma unroll 1
    for (int q = 0; q < nq; q += 2) {
        if (q + 1 < nq) pool_load<HW>(F, q + 1, B);
        pool_compute<HW>(F, q, A);
        if (q + 2 < nq) pool_load<HW>(F, q + 2, A);
        if (q + 1 < nq) pool_compute<HW>(F, q + 1, B);
    }
}
__device__ __forceinline__ void pool_phase(const Ctx& F) {
    switch (F.wave >> 1) { case 0: pool_stream<1>(F); break; case 1: pool_stream<2>(F); break; case 2: pool_stream<4>(F); break; default: pool_stream<8>(F); break; }
}

constexpr int AT_ROWS = 80, AT_SLOTS = 9, AT_KR = 0, AT_VR = AT_SLOTS * 8192, AT_RPB = 2 * AT_SLOTS * 8192;
static_assert(AT_RPB + 15 * 32 * 4 <= LDS_BYTES && (NBATCH * GRID_H) % AT_ROWS == 0 && AT_ROWS % 2 == 0, "attention LDS map / chunking");
__device__ __forceinline__ int at_rs(int R) { const int r = R & 127, t = r - 4; return (R & ~127) + (t < 0 ? 0 : (t > GRID_H - 8 ? GRID_H - 8 : t)); }
__device__ __forceinline__ void attn_phase(const Ctx& F) {
    LAS unsigned char* KR = F.lds + AT_KR; LAS unsigned char* VR = F.lds + AT_VR; LAS float* rpbL = (LAS float*)(F.lds + AT_RPB);
    const int tid = F.tid, lane = F.lane, g = lane >> 4, li = lane & 15, wsel = F.wave >> 2, j = F.wave & 3;
    const int kc0 = (j == 0) ? 0 : (j == 1) ? 8 : (j == 2) ? 24 : 32, c = 16 * j + li, cs = (c - 8) < 0 ? 0 : ((c - 8) > GRID_W - 16 ? GRID_W - 16 : (c - 8));
    int boff[8];
#pragma unroll
    for (int hf = 0; hf < 2; ++hf)
#pragma unroll
        for (int i = 0; i < 4; ++i) { const int kc = kc0 + 16 * hf + 4 * g + i; boff[4 * hf + i] = ((kc >= cs) && (kc < cs + 16)) ? (kc - c + 15) : 31; }
    int koff[2][2], voff[4][2];
#pragma unroll
    for (int hf = 0; hf < 2; ++hf) { const int row = kc0 + 16 * hf + li, sw = (row >> 1) & 7; koff[hf][0] = row * 128 + ((g ^ sw) << 4); koff[hf][1] = row * 128 + (((4 + g) ^ sw) << 4); }
#pragma unroll
    for (int nb = 0; nb < 4; ++nb) { const int row = nb * 16 + li, sw = (row >> 1) & 7;
#pragma unroll
        for (int hf = 0; hf < 2; ++hf) { const int u = (kc0 >> 2) + g + 4 * hf; voff[nb][hf] = row * 128 + (((u >> 1) ^ sw) << 4) + ((u & 1) << 3); } }
    const int srow = tid >> 3, sch = tid & 7, sdst = srow * 128 + ((sch ^ ((srow >> 1) & 7)) << 4);
    for (int item = F.vcu; item < 256; item += F.G) {
        const int combo = item & 15, h = combo >> 1, e = combo & 1, Rbase = (item >> 4) * AT_ROWS;
        const bf16* ksrc = F.Z + (size_t)srow * NZ + ZK + h * 64 + sch * 8;
        const bf16* vsrc = F.VT + (size_t)(h * 128 + e * 64 + srow) * M + sch * 8;
        __syncthreads();
        for (int i = tid; i < 15 * 32; i += NTHR) rpbL[i] = ((i & 31) < 31) ? F.rpb[h * 465 + (i >> 5) * 31 + (i & 31)] * 1.4426950408889634f : -INFINITY;
        int cur_hi = at_rs(Rbase);
        { const int nhi = at_rs(Rbase + 1) + 8;
          for (; cur_hi < nhi; ++cur_hi) { const int sl = cur_hi % AT_SLOTS;
              const u32x4 kv = *(const u32x4*)(ksrc + (size_t)cur_hi * 64 * NZ), vv = *(const u32x4*)(vsrc + (size_t)cur_hi * 64);
              *(LAS u32x4*)(KR + sl * 8192 + sdst) = kv; *(LAS u32x4*)(VR + sl * 8192 + sdst) = vv; } }
        bf16x8 Q0, Q1;
        { const bf16* qp = F.Z + ((size_t)(Rbase + wsel) * 64 + c) * NZ + ZQ + h * 64 + 8 * g; Q0 = *(const bf16x8*)qp; Q1 = *(const bf16x8*)(qp + 32); }
        __syncthreads();
#pragma unroll 1
        for (int step = 0; step < AT_ROWS / 2; ++step) {
            const int R0 = Rbase + 2 * step, R = R0 + wsel; const bool more = step + 1 < AT_ROWS / 2;
            int nhi = 0, pf_n = 0, pf_row = 0; u32x4 sk0, sv0, sk1, sv1; bf16x8 Qn0 = Q0, Qn1 = Q1;
            if (more) { const int nlo = at_rs(R0 + 2); nhi = at_rs(R0 + 3) + 8; if (cur_hi < nlo) cur_hi = nlo; pf_row = cur_hi; pf_n = nhi - cur_hi; pf_n = pf_n > 2 ? 2 : pf_n;
                if (pf_n > 0) { sk0 = *(const u32x4*)(ksrc + (size_t)pf_row * 64 * NZ); sv0 = *(const u32x4*)(vsrc + (size_t)pf_row * 64); }
                if (pf_n > 1) { sk1 = *(const u32x4*)(ksrc + (size_t)(pf_row + 1) * 64 * NZ); sv1 = *(const u32x4*)(vsrc + (size_t)(pf_row + 1) * 64); }
                const bf16* qp = F.Z + ((size_t)(R + 2) * 64 + c) * NZ + ZQ + h * 64 + 8 * g; Qn0 = *(const bf16x8*)qp; Qn1 = *(const bf16x8*)(qp + 32); }
            const int rsf = at_rs(R), slot0 = rsf % AT_SLOTS; const size_t tok = (size_t)R * 64 + c;
            const bf16* gap = F.Z + tok * NZ + ZGA + h * 128 + e * 64 + 4 * g; bf16* mp = F.MX + tok * D + h * 128 + e * 64 + 4 * g;
            u32x2 gav[4], mxv[4];
#pragma unroll
            for (int nb = 0; nb < 4; ++nb) { gav[nb] = *(const u32x2*)(gap + nb * 16); mxv[nb] = *(const u32x2*)(mp + nb * 16); }
            f32x4 sacc[8][2]; int sl = slot0; const LAS float* rp0 = rpbL + (rsf - R + 7) * 32;
#pragma unroll
            for (int kr = 0; kr < 8; ++kr) { const LAS unsigned char* kb = KR + sl * 8192; const LAS float* rp = rp0 + kr * 32;
#pragma unroll
                for (int hf = 0; hf < 2; ++hf) { const bf16x8 K0 = *(const LAS bf16x8*)(kb + koff[hf][0]), K1 = *(const LAS bf16x8*)(kb + koff[hf][1]);
                    f32x4 a; a[0] = rp[boff[4 * hf + 0]]; a[1] = rp[boff[4 * hf + 1]]; a[2] = rp[boff[4 * hf + 2]]; a[3] = rp[boff[4 * hf + 3]];
                    a = __builtin_amdgcn_mfma_f32_16x16x32_bf16(K0, Q0, a, 0, 0, 0); a = __builtin_amdgcn_mfma_f32_16x16x32_bf16(K1, Q1, a, 0, 0, 0); sacc[kr][hf] = a; }
                sl = (sl + 1 == AT_SLOTS) ? 0 : sl + 1; }
            float mx = -INFINITY;
#pragma unroll
            for (int kr = 0; kr < 8; ++kr)
#pragma unroll
                for (int hf = 0; hf < 2; ++hf) mx = fmaxf(fmaxf(mx, fmaxf(sacc[kr][hf][0], sacc[kr][hf][1])), fmaxf(sacc[kr][hf][2], sacc[kr][hf][3]));
            mx = fmaxf(mx, __shfl_xor(mx, 16)); mx = fmaxf(mx, __shfl_xor(mx, 32));
            float sum = 0.f; bf16x8 Pf[8];
#pragma unroll
            for (int kr = 0; kr < 8; ++kr) { float p[8];
#pragma unroll
                for (int hf = 0; hf < 2; ++hf)
#pragma unroll
                    for (int i = 0; i < 4; ++i) { const float pv = __builtin_amdgcn_exp2f(sacc[kr][hf][i] - mx); p[4 * hf + i] = pv; sum += pv; }
                u32x4 w; w.x = pg8::cvt_pk_bf16(p[0], p[1]); w.y = pg8::cvt_pk_bf16(p[2], p[3]); w.z = pg8::cvt_pk_bf16(p[4], p[5]); w.w = pg8::cvt_pk_bf16(p[6], p[7]);
                Pf[kr] = __builtin_bit_cast(bf16x8, w); }
            sum += __shfl_xor(sum, 16); sum += __shfl_xor(sum, 32);
            const float inv = 1.0f / sum;
            f32x4 oacc[4];
#pragma unroll
            for (int nb = 0; nb < 4; ++nb) oacc[nb] = (f32x4){0.f, 0.f, 0.f, 0.f};
            sl = slot0;
#pragma unroll
            for (int kr = 0; kr < 8; ++kr) { const LAS unsigned char* vb = VR + sl * 8192;
#pragma unroll
                for (int nb = 0; nb < 4; ++nb) { const u32x2 lo = *(const LAS u32x2*)(vb + voff[nb][0]), hi = *(const LAS u32x2*)(vb + voff[nb][1]); const u32x4 w = {lo.x, lo.y, hi.x, hi.y};
                    oacc[nb] = __builtin_amdgcn_mfma_f32_16x16x32_bf16(__builtin_bit_cast(bf16x8, w), Pf[kr], oacc[nb], 0, 0, 0); }
                sl = (sl + 1 == AT_SLOTS) ? 0 : sl + 1; }
#pragma unroll
            for (int nb = 0; nb < 4; ++nb) { const u32x2 ga = gav[nb], pa = mxv[nb];
                const float o0 = bflo(pa.x) + sigm(bflo(ga.x)) * oacc[nb][0] * inv, o1 = bfhi(pa.x) + sigm(bfhi(ga.x)) * oacc[nb][1] * inv;
                const float o2 = bflo(pa.y) + sigm(bflo(ga.y)) * oacc[nb][2] * inv, o3 = bfhi(pa.y) + sigm(bfhi(ga.y)) * oacc[nb][3] * inv;
                u32x2 w; w.x = pg8::cvt_pk_bf16(o0, o1); w.y = pg8::cvt_pk_bf16(o2, o3); *(u32x2*)(mp + nb * 16) = w; }
            __syncthreads();
            if (pf_n > 0) { const int s0 = pf_row % AT_SLOTS; *(LAS u32x4*)(KR + s0 * 8192 + sdst) = sk0; *(LAS u32x4*)(VR + s0 * 8192 + sdst) = sv0; }
            if (pf_n > 1) { const int s1 = (pf_row + 1) % AT_SLOTS; *(LAS u32x4*)(KR + s1 * 8192 + sdst) = sk1; *(LAS u32x4*)(VR + s1 * 8192 + sdst) = sv1; }
            cur_hi += pf_n;
            if (more) for (; cur_hi < nhi; ++cur_hi) { const int s2 = cur_hi % AT_SLOTS;
                const u32x4 kv = *(const u32x4*)(ksrc + (size_t)cur_hi * 64 * NZ), vv = *(const u32x4*)(vsrc + (size_t)cur_hi * 64);
                *(LAS u32x4*)(KR + s2 * 8192 + sdst) = kv; *(LAS u32x4*)(VR + s2 * 8192 + sdst) = vv; }
            Q0 = Qn0; Q1 = Qn1;
            __syncthreads();
        }
    }
}

struct NormRow { f32x4 x[4]; u32x2 t[4]; float ps; };
template <bool SECOND> __device__ __forceinline__ void norm_load(const Ctx& F, int m, int lane, NormRow& r) {
    const f32x4* xr = (const f32x4*)(SECOND ? F.out + (size_t)m * D : xrow(F, m)) + lane; const u32x2* tr = (const u32x2*)((SECOND ? F.FO : F.T) + (size_t)m * D) + lane;
#pragma unroll
    for (int j = 0; j < 4; ++j) { r.x[j] = xr[64 * j]; r.t[j] = tr[64 * j]; }
    r.ps = F.PS[(size_t)m * 16 + (lane & 15)];
}
template <bool SECOND> __device__ __forceinline__ void norm_rows(const Ctx& F) {
    const int gw = F.vcu * NWAVES + F.wave, NGW = F.G * NWAVES, lane = F.lane;
    const float* gpost = SECOND ? F.g_ffn_post : F.g_mix_post;
    f32x4 gv[4];
#pragma unroll
    for (int j = 0; j < 4; ++j) gv[j] = ((const f32x4*)gpost)[64 * j + lane];
    NormRow cur, nxt;
    if (gw < M) norm_load<SECOND>(F, gw, lane, cur);
#pragma unroll 1
    for (int m = gw; m < M; m += NGW) {
        nxt = cur;
        if (m + NGW < M) norm_load<SECOND>(F, m + NGW, lane, nxt);
        float ss = cur.ps;
        ss += __shfl_xor(ss, 1); ss += __shfl_xor(ss, 2); ss += __shfl_xor(ss, 4); ss += __shfl_xor(ss, 8);
        const float rstdT = 1.0f / sqrtf(ss * (1.f / D) + EPS);
        f32x4 v[4]; float s2 = 0.f;
#pragma unroll
        for (int j = 0; j < 4; ++j) { const f32x4 xv = cur.x[j]; const u32x2 t = cur.t[j];
            v[j].x = xv.x + bflo(t.x) * rstdT * gv[j].x; v[j].y = xv.y + bfhi(t.x) * rstdT * gv[j].y; v[j].z = xv.z + bflo(t.y) * rstdT * gv[j].z; v[j].w = xv.w + bfhi(t.y) * rstdT * gv[j].w;
            s2 += (v[j].x * v[j].x + v[j].y * v[j].y) + (v[j].z * v[j].z + v[j].w * v[j].w); }
        f32x4* orow = (f32x4*)(F.out + (size_t)m * D) + lane;
#pragma unroll
        for (int j = 0; j < 4; ++j) orow[64 * j] = v[j];
        if (!SECOND) {
            const float rstd = 1.0f / sqrtf(wave_sum(s2) * (1.f / D) + EPS);
            unsigned long long* o8 = (unsigned long long*)(F.H2 + (size_t)m * D) + lane;
#pragma unroll
            for (int j = 0; j < 4; ++j) o8[64 * j] = (unsigned long long)pk2(v[j].x * rstd, v[j].y * rstd) | ((unsigned long long)pk2(v[j].z * rstd, v[j].w * rstd) << 32);
        }
        cur = nxt;
    }
}

#define REP_P0 1
#define REP_P2 1
#define REP_P4 1
#define REP_G 1
__global__ void __launch_bounds__(NTHR, 2) enc_fwd(Args args) {
    extern __shared__ __attribute__((aligned(16))) unsigned char lds[];
    cg::grid_group grid = cg::this_grid();
    Ctx F;
    F.lds = (LAS unsigned char*)lds;
    F.tid = threadIdx.x; F.lane = F.tid & 63; F.wave = __builtin_amdgcn_readfirstlane(F.tid >> 6);
    F.G = gridDim.x; { const int bx = blockIdx.x; F.vcu = (F.G % 8 == 0) ? (bx % 8) * (F.G / 8) + bx / 8 : bx; }
    unsigned char* ws = args.ws;
    F.xp = args.in[0]; F.xs = args.in[1]; F.g_mix_pre = args.in[2]; F.w_in = args.in[3]; F.w_grp = args.in[4]; F.pool_scale = args.in[5]; F.rpb = args.in[6]; F.w_out = args.in[7];
    F.g_mix_post = args.in[8]; F.g_ffn_pre = args.in[9]; F.w_gu = args.in[10]; F.w_down = args.in[11]; F.g_ffn_post = args.in[12]; F.out = args.out;
    F.W1t = (bf16*)(ws + WS_W1); F.Wvt = (bf16*)(ws + WS_WV); F.W2t = (bf16*)(ws + WS_W2); F.W3t = (bf16*)(ws + WS_W3); F.W4t = (bf16*)(ws + WS_W4); F.PS = (float*)(ws + WS_PS);
    F.XN = (bf16*)(ws + WS_XN); F.MX = F.XN; F.FO = F.XN; F.Z = (bf16*)(ws + WS_Z); F.ACT = F.Z; F.H2 = (bf16*)(ws + WS_H2); F.VT = (bf16*)(ws + WS_VT); F.T = F.VT;
    if (F.tid < 16) ((LAS unsigned*)(F.lds + MISC_OFF))[F.tid] = 0u;
    __syncthreads();
    const XcdBarrier bar = xcd_barrier_post((unsigned*)(ws + WS_CTL) + CW_BAR, (volatile LAS unsigned*)(F.lds + MISC_OFF));
    const int lo = args.ph_lo, hi = args.ph_hi;
#define IN(k) (lo <= (k) && (k) < hi)
#define SEAM(k) do { if (IN(k) && IN((k) + 1)) { if ((k) == 0) grid.sync(); else xcd_barrier(bar); } } while (0)
#define REPEAT(n) for (int rep_ = 0; rep_ < (n); ++rep_, ((rep_ < (n)) ? grid.sync() : (void)0))
    if (IN(0)) { REPEAT(REP_P0) p0_prologue(F); } SEAM(0);
    if (IN(1)) { REPEAT(REP_G) {
        { pg8::Gemm g{F.XN, F.W1t, M, NZ, D}; pg8::StaticOrder S; S.init(M, NZ, F.G, (int)blockIdx.x); pg8::EpiPlain E{F.Z, NZ};
          pg8::gemm_phase<pg8::EpiPlain, pg8::StaticOrder, true, true>(F.lds, g, S, E); }
        { pg8::Gemm g{F.Wvt, F.XN, D, M, D}; pg8::StaticOrder S; S.init(D, M, F.G, (int)blockIdx.x); pg8::EpiPlain E{F.VT, M};
          pg8::gemm_phase<pg8::EpiPlain, pg8::StaticOrder, true, true>(F.lds, g, S, E); } }
    } SEAM(1);
    if (IN(2)) { REPEAT(REP_P2) pool_phase(F); } SEAM(2);
    if (IN(3)) { attn_phase(F); } SEAM(3);
    if (IN(4)) { REPEAT(REP_G) { pg8::Gemm g{F.MX, F.W2t, M, D, D}; pg8::StaticOrder S; S.init(M, D, F.G, (int)blockIdx.x); pg8::EpiSumsq E{F.T, D, F.PS};
        pg8::gemm_phase<pg8::EpiSumsq, pg8::StaticOrder, true, true>(F.lds, g, S, E); } } SEAM(4);
    if (IN(5)) { REPEAT(REP_P4) norm_rows<false>(F); } SEAM(5);
    if (IN(6)) { REPEAT(REP_G) { pg8::Gemm g{F.H2, F.W3t, M, 2 * DFF, D}; pg8::StaticOrder S; S.init(M, 2 * DFF, F.G, (int)blockIdx.x); pg8::EpiSwiglu E{F.ACT, DFF};
        pg8::gemm_phase<pg8::EpiSwiglu, pg8::StaticOrder, true, true>(F.lds, g, S, E); } } SEAM(6);
    if (IN(7)) { REPEAT(REP_G) { pg8::Gemm g{F.ACT, F.W4t, M, D, DFF}; pg8::StaticOrder S; S.init(M, D, F.G, (int)blockIdx.x); pg8::EpiSumsq E{F.FO, D, F.PS};
        pg8::gemm_phase<pg8::EpiSumsq, pg8::StaticOrder, true, true>(F.lds, g, S, E); } } SEAM(7);
    if (IN(8)) { norm_rows<true>(F); }
#undef REPEAT
#undef IN
#undef SEAM
}

#ifndef MK_PER_PHASE
#define MK_PER_PHASE 0
#endif
extern "C" void kernel_launch(void* const* d_in, const int* in_sizes, int n_in, void* d_out, int out_size, void* d_ws, size_t ws_size, hipStream_t stream) {
    static int grid = 0;
    if (grid == 0) {
        if (n_in != 13 || out_size != M * D || ws_size < WS_END) { fprintf(stderr, "kernel_launch: unexpected problem (n_in %d, out %d, ws %zu); nothing launched\n", n_in, out_size, ws_size); grid = -1; return; }
        int dev = 0, cus = 0, per_cu = 0;
        if (hipGetDevice(&dev) != hipSuccess || hipDeviceGetAttribute(&cus, hipDeviceAttributeMultiprocessorCount, dev) != hipSuccess) { grid = -1; return; }
        if (hipFuncSetAttribute((const void*)enc_fwd, hipFuncAttributeMaxDynamicSharedMemorySize, LDS_BYTES) != hipSuccess) { fprintf(stderr, "kernel_launch: hipFuncSetAttribute failed\n"); grid = -1; return; }
        if (hipOccupancyMaxActiveBlocksPerMultiprocessor(&per_cu, (const void*)enc_fwd, NTHR, LDS_BYTES) != hipSuccess || per_cu < 1) { fprintf(stderr, "kernel_launch: occupancy query says %d\n", per_cu); per_cu = 1; }
        (void)hipGetLastError();
        grid = cus;
    }
    if (grid < 0) return;
    if (hipMemsetAsync((char*)d_ws + WS_CTL, 0, CTL_ZERO_BYTES, stream) != hipSuccess) { fprintf(stderr, "kernel_launch: hipMemsetAsync failed\n"); return; }
    Args a{};
    for (int i = 0; i < 13; ++i) a.in[i] = (const float*)d_in[i];
    a.out = (float*)d_out; a.ws = (unsigned char*)d_ws;
#if MK_PER_PHASE
    for (int p = 0; p < 9; ++p) { a.ph_lo = p; a.ph_hi = p + 1; hipLaunchKernelGGL(enc_fwd, dim3(grid), dim3(NTHR), LDS_BYTES, stream, a); }
#else
    a.ph_lo = 0; a.ph_hi = 9;
    void* kargs[] = {&a};
    const hipError_t e = hipLaunchCooperativeKernel((const void*)enc_fwd, dim3(grid), dim3(NTHR), kargs, LDS_BYTES, stream);
    if (e != hipSuccess) fprintf(stderr, "kernel_launch: cooperative launch failed: %s (grid %d)\n", hipGetErrorString(e), grid);
#endif
}
```
